# Optimizing an MI355X kernel written in HIP

```python
import math
import jax, jax.numpy as jnp
from jax import lax
import numpy as np

D_MODEL = 4096
BATCH = 2
SEQ = 8192
DEPTH = 1

CHUNK = 64
HEAD_DIM = 128
N_HEADS_A = 16
N_HEADS_B = 16
D_A = N_HEADS_A * HEAD_DIM
D_B = N_HEADS_B * HEAD_DIM
N_IDX_HEADS = 32
IDX_DIM = 64
TOPK_MAX = 256
N_BUCKETS = 32
MAX_DISTANCE = 1024
D_FF = 4 * D_MODEL
Q_BLOCK = 128
EPS = 1e-6
SPLIT_SIZES = (D_A, D_A, D_A, N_IDX_HEADS * IDX_DIM, IDX_DIM, N_IDX_HEADS,
               D_B, D_B, D_B, N_HEADS_B, D_MODEL, D_MODEL)
D_IN = sum(SPLIT_SIZES)

kernel_name = 'hybrid_dsa_fox_gated_block'


def rmsnorm(x, g):
    x32 = x.astype(jnp.float32)
    y = x32 * lax.rsqrt(jnp.mean(x32 * x32, axis=-1, keepdims=True) + EPS)
    return y.astype(x.dtype) * g


def t5_bucket(rel):
    half = N_BUCKETS // 2
    max_exact = half // 2
    base = jnp.where(rel > 0, half, 0)
    n = jnp.abs(rel)
    nf = jnp.maximum(n, max_exact).astype(jnp.float32)
    large = max_exact + (jnp.log(nf / max_exact) / math.log(MAX_DISTANCE / max_exact)
                         * (half - max_exact)).astype(jnp.int32)
    large = jnp.minimum(large, half - 1)
    return base + jnp.where(n < max_exact, n, large)


def dsa_attention(q, k, v, iq, ik, iw, rel_bias):
    B, S = q.shape[0], q.shape[1]
    n_blocks = S // CHUNK
    top_k = min(TOPK_MAX, S // 4)
    key_pos = jnp.arange(S, dtype=jnp.int32)
    b_idx = jnp.arange(B)[:, None, None]
    scale = HEAD_DIM ** -0.5

    def block(c):
        start = c * CHUNK
        qb = lax.dynamic_slice_in_dim(q, start, CHUNK, axis=1)
        iqb = lax.dynamic_slice_in_dim(iq, start, CHUNK, axis=1)
        iwb = lax.dynamic_slice_in_dim(iw, start, CHUNK, axis=1)
        sc = jnp.einsum('bthd,bsd->bths', iqb, ik) * (IDX_DIM ** -0.5)
        score = jnp.einsum('bths,bth->bts', jax.nn.relu(sc), iwb).astype(jnp.float32)
        limit = start + CHUNK
        score = jnp.where(key_pos[None, None, :] < limit, score, -jnp.inf)
        _, idx = lax.top_k(score, top_k)
        valid = idx < limit
        kg = k[b_idx, idx]
        vg = v[b_idx, idx]
        logits = jnp.einsum('bthd,btkhd->bhtk', qb, kg).astype(jnp.float32) * scale
        q_pos = start + jnp.arange(CHUNK, dtype=jnp.int32)
        bias = rel_bias[t5_bucket(idx - q_pos[None, :, None])]
        logits = logits + jnp.transpose(bias, (0, 3, 1, 2)).astype(jnp.float32)
        logits = jnp.where(valid[:, None, :, :], logits, -jnp.inf)
        p = jax.nn.softmax(logits, axis=-1)
        return jnp.einsum('bhtk,btkhd->bthd', p.astype(v.dtype), vg)

    out = lax.map(block, jnp.arange(n_blocks))
    out = jnp.transpose(out, (1, 0, 2, 3, 4))
    return out.reshape(B, S, N_HEADS_A * HEAD_DIM)


def fox_attention(q, k, v, log_f):
    B, S = q.shape[0], q.shape[1]
    n_blocks = S // Q_BLOCK
    cum = jnp.transpose(lax.cumsum(log_f, axis=1), (0, 2, 1))
    key_pos = jnp.arange(S, dtype=jnp.int32)
    scale = HEAD_DIM ** -0.5

    def block(i):
        start = i * Q_BLOCK
        qb = lax.dynamic_slice_in_dim(q, start, Q_BLOCK, axis=1)
        cq = lax.dynamic_slice_in_dim(cum, start, Q_BLOCK, axis=2)
        logits = jnp.einsum('bthd,bshd->bhts', qb, k).astype(jnp.float32) * scale
        logits = logits + cq[:, :, :, None] - cum[:, :, None, :]
        q_pos = start + jnp.arange(Q_BLOCK, dtype=jnp.int32)
        logits = jnp.where(key_pos[None, :] <= q_pos[:, None], logits, -jnp.inf)
        p = jax.nn.softmax(logits, axis=-1)
        return jnp.einsum('bhts,bshd->bthd', p.astype(v.dtype), v)

    out = lax.map(block, jnp.arange(n_blocks))
    out = jnp.transpose(out, (1, 0, 2, 3, 4))
    return out.reshape(B, S, N_HEADS_B * HEAD_DIM)


def setup_inputs(seed: int = 0) -> dict:
    key = jax.random.key(seed)
    ks = jax.random.split(key, 12)
    f32 = jnp.float32
    x = jax.random.normal(ks[0], (BATCH, SEQ, D_MODEL), f32)
    w_in = jax.random.normal(ks[1], (DEPTH, D_MODEL, D_IN), f32) * D_MODEL ** -0.5
    b_f = 2.0 + 0.5 * jax.random.normal(ks[2], (DEPTH, N_HEADS_B), f32)
    w_out_a = jax.random.normal(ks[3], (DEPTH, D_A, D_MODEL), f32) * D_A ** -0.5
    w_out_b = jax.random.normal(ks[4], (DEPTH, D_B, D_MODEL), f32) * D_B ** -0.5
    w_o = jax.random.normal(ks[5], (DEPTH, D_MODEL, D_MODEL), f32) * D_MODEL ** -0.5
    w_up = jax.random.normal(ks[6], (DEPTH, D_MODEL, D_FF), f32) * D_MODEL ** -0.5
    w_down = jax.random.normal(ks[7], (DEPTH, D_FF, D_MODEL), f32) * D_FF ** -0.5
    g_mix = 1.0 + 0.01 * jax.random.normal(ks[8], (DEPTH, D_MODEL), f32)
    g_mlp = 1.0 + 0.01 * jax.random.normal(ks[9], (DEPTH, D_MODEL), f32)
    g_final = 1.0 + 0.01 * jax.random.normal(ks[10], (D_MODEL,), f32)
    rel_bias = 0.5 * jax.random.normal(ks[11], (N_BUCKETS, N_HEADS_A), f32)
    return {'x': x, 'w_in': w_in, 'b_f': b_f, 'w_out_a': w_out_a, 'w_out_b': w_out_b,
            'w_o': w_o, 'w_up': w_up, 'w_down': w_down, 'g_mix': g_mix, 'g_mlp': g_mlp,
            'g_final': g_final, 'rel_bias': rel_bias}


def reference(x, w_in, b_f, w_out_a, w_out_b, w_o, w_up, w_down, g_mix, g_mlp, g_final, rel_bias):
    B, S = x.shape[0], x.shape[1]
    split_points = [int(p) for p in np.cumsum(SPLIT_SIZES)[:-1]]
    for l in range(DEPTH):
        xn = rmsnorm(x, g_mix[l])
        proj = jnp.einsum('bsd,de->bse', xn, w_in[l])
        qa, ka, va, iq, ik, iw, qb, kb, vb, fl, ga, gb = jnp.split(proj, split_points, axis=-1)
        ya = dsa_attention(qa.reshape(B, S, N_HEADS_A, HEAD_DIM),
                           ka.reshape(B, S, N_HEADS_A, HEAD_DIM),
                           va.reshape(B, S, N_HEADS_A, HEAD_DIM),
                           iq.reshape(B, S, N_IDX_HEADS, IDX_DIM), ik,
                           iw * (N_IDX_HEADS ** -0.5), rel_bias)
        log_f = jax.nn.log_sigmoid(fl.astype(jnp.float32) + b_f[l].astype(jnp.float32))
        yb = fox_attention(qb.reshape(B, S, N_HEADS_B, HEAD_DIM),
                           kb.reshape(B, S, N_HEADS_B, HEAD_DIM),
                           vb.reshape(B, S, N_HEADS_B, HEAD_DIM), log_f)
        pa = jnp.einsum('bse,ed->bsd', ya, w_out_a[l])
        pb = jnp.einsum('bse,ed->bsd', yb, w_out_b[l])
        merged = jax.nn.sigmoid(ga) * pa + jax.nn.sigmoid(gb) * pb
        x = x + jnp.einsum('bsd,de->bse', merged, w_o[l])
        hn = rmsnorm(x, g_mlp[l])
        h = jnp.square(jax.nn.relu(jnp.einsum('bsd,df->bsf', hn, w_up[l])))
        x = x + jnp.einsum('bsf,fd->bsd', h, w_down[l])
    return rmsnorm(x, g_final)
```

```cpp
#include <hip/hip_runtime.h>
#include <cstdio>
#include <cstdint>

namespace pg8 {
#define PG8_LAS __attribute__((address_space(3)))
typedef unsigned short bf16_t;
typedef short bf16x8 __attribute__((ext_vector_type(8)));
typedef _Float16 f16x8 __attribute__((ext_vector_type(8)));
typedef float f32x4 __attribute__((ext_vector_type(4)));
typedef float f32x2 __attribute__((ext_vector_type(2)));
typedef unsigned u32x4 __attribute__((ext_vector_type(4)));
typedef unsigned u32x2 __attribute__((ext_vector_type(2)));
typedef int i32x4 __attribute__((ext_vector_type(4)));
typedef int i32x8 __attribute__((ext_vector_type(8)));
constexpr int BM = 256, BK = 64, HALF = 128, HTB = HALF * BK * 2, STAGE_BYTES = 8 * HTB, NXCD = 8, WGM = 8;

__host__ __device__ __forceinline__ int lds_byte(int r, int c) { const int st = (r >> 4) * 2 + (c >> 5), rr = r & 15, cc = c & 31, ob = rr * 64 + cc * 2; return st * 1024 + (ob ^ (((ob >> 9) & 1) << 5)); }
__host__ __device__ __forceinline__ void stage_rc(int b, int& R, int& C) { const int st = b / 1024, sb = b % 1024, swz = sb ^ (((sb >> 9) & 1) << 5); R = (st >> 1) * 16 + swz / 64; C = (st & 1) * 32 + (swz % 64) / 2; }
__host__ __device__ __forceinline__ int perm32(int rho) { const int n = rho >> 4, i = rho & 15; return 8 * (i >> 2) + 4 * n + (i & 3); }

struct Unit { int pm, pn; };
struct Gemm { const bf16_t* A; const bf16_t* Bt; int M, N, K; };

struct StaticOrder {
    int nM, nN, nwg, G, c, wgm;
    __host__ __device__ void init(int M, int N, int G_, int c_, int wgm_ = WGM) { nM = M / BM; nN = N / BM; nwg = nM * nN; G = G_; c = c_; wgm = wgm_; }
    __host__ __device__ bool next(int i, Unit& u) const {
        const long L = (long)i * G + c; if (L >= nwg) return false;
        int wgid = (int)L; { const int q = nwg / NXCD, r = nwg % NXCD, xcd = wgid % NXCD, off = wgid / NXCD; wgid = (xcd < r ? xcd * (q + 1) : r * (q + 1) + (xcd - r) * q) + off; }
        const int nig = wgm * nN, gid = wgid / nig, fm = gid * wgm, gsz = (nM - fm) < wgm ? (nM - fm) : wgm;
        u.pm = fm + ((wgid % nig) % gsz); u.pn = (wgid % nig) / gsz; return true;
    }
    __device__ __forceinline__ void a_ready(const Unit&) const {}
    __device__ __forceinline__ void done(const Unit&) const {}
};
typedef __bf16 bf16x2_t __attribute__((ext_vector_type(2)));
__device__ __forceinline__ unsigned cvt_pk_bf16(float lo, float hi) { f32x2 v = {lo, hi}; return __builtin_bit_cast(unsigned, __builtin_convertvector(v, bf16x2_t)); }
__device__ __forceinline__ unsigned cvt_pk_f16(float lo, float hi) { typedef _Float16 h2 __attribute__((ext_vector_type(2))); h2 v; v.x = (_Float16)lo; v.y = (_Float16)hi; return __builtin_bit_cast(unsigned, v); }
__device__ __forceinline__ float bf_lo(unsigned w) { return __builtin_bit_cast(float, w << 16); }
__device__ __forceinline__ float bf_hi(unsigned w) { return __builtin_bit_cast(float, w & 0xffff0000u); }

template <class Epi, class Sched, int MT  , bool ALIGN_EPI = true, bool SP2 = true>
__device__ __forceinline__ void gemm_phase(PG8_LAS unsigned char* lds, const Gemm g, const Sched& S, const Epi& E) {
    int tid_ = threadIdx.x; asm volatile("" : "+v"(tid_));
    const int tid = tid_, wid = __builtin_amdgcn_readfirstlane(tid >> 6), lane = tid & 63, wr = wid >> 2, wc = wid & 3, fr = lane & 15, fq = lane >> 4;
    const int K = g.K, nt = K / BK;
    unsigned voffA[2], voffB[2];
#pragma unroll
    for (int i = 0; i < 2; ++i) { int R, C; stage_rc(tid * 16 + i * 8192, R, C); const int Rb = Epi::PERM ? ((R & ~31) + perm32(R & 31)) : R;
        voffA[i] = (unsigned)(R * K + C) * 2u; voffB[i] = (unsigned)(Rb * K + C) * 2u; }
    const size_t kstep = (size_t)(BK * 2);
    const size_t hstep = (size_t)HALF * K * 2;
    const size_t tstep = 2 * hstep;
    const unsigned ldsw = (unsigned)wid * 1024u;
    const int aoff = lds_byte(wr * 64 + fr, fq * 8), boff = lds_byte(wc * 32 + fr, fq * 8);
#define PG8_SA(b, h) (((b) * 2 + (h)) * HTB)
#define PG8_SB(b, h) ((4 + (b) * 2 + (h)) * HTB)
#define PG8_STAGE(bufoff, gbase, voff) do { _Pragma("unroll") for (int _i = 0; _i < 2; ++_i) \
        __builtin_amdgcn_global_load_lds((const unsigned*)((const char*)(gbase) + (voff)[_i]), (PG8_LAS unsigned*)(lds + (bufoff) + ldsw + _i * 8192), 16, 0, 0); } while (0)
#define PG8_LDA(dst, b, h) do { _Pragma("unroll") for (int m = 0; m < 4; ++m) _Pragma("unroll") for (int k = 0; k < 2; ++k) dst[m][k] = *(const PG8_LAS bf16x8*)(lds + PG8_SA(b, h) + aoff + m * 2048 + k * 1024); } while (0)
#define PG8_LDB(dst, b, h) do { _Pragma("unroll") for (int n = 0; n < 2; ++n) _Pragma("unroll") for (int k = 0; k < 2; ++k) dst[n][k] = *(const PG8_LAS bf16x8*)(lds + PG8_SB(b, h) + boff + n * 2048 + k * 1024); } while (0)
#define PG8_MMA(ai, bj, At, Bt) do { __builtin_amdgcn_s_setprio(1); _Pragma("unroll") for (int m = 0; m < 4; ++m) _Pragma("unroll") for (int n = 0; n < 2; ++n) { \
        if constexpr (MT == 2) {   \
            const i32x8 b8_ = __builtin_shufflevector(__builtin_bit_cast(i32x4, Bt[n][0]), __builtin_bit_cast(i32x4, Bt[n][1]), 0, 1, 2, 3, 4, 5, 6, 7); \
            const i32x8 a8_ = __builtin_shufflevector(__builtin_bit_cast(i32x4, At[m][0]), __builtin_bit_cast(i32x4, At[m][1]), 0, 1, 2, 3, 4, 5, 6, 7); \
              \
            asm volatile("v_mfma_scale_f32_16x16x128_f8f6f4 %0, %1, %2, %0, %3, %3 op_sel_hi:[0,0,0]" : "+v"(acc[ai][bj][m][n]) : "v"(b8_), "v"(a8_), "v"(0x7f7f7f7f)); } \
        else { _Pragma("unroll") for (int k = 0; k < 2; ++k) { \
        if constexpr (MT == 1) acc[ai][bj][m][n] = __builtin_amdgcn_mfma_f32_16x16x32_f16(__builtin_bit_cast(f16x8, Bt[n][k]), __builtin_bit_cast(f16x8, At[m][k]), acc[ai][bj][m][n], 0, 0, 0); \
        else acc[ai][bj][m][n] = __builtin_amdgcn_mfma_f32_16x16x32_bf16(Bt[n][k], At[m][k], acc[ai][bj][m][n], 0, 0, 0); } } } __builtin_amdgcn_s_setprio(0); } while (0)
#define PG8_WAIT_V(n) asm volatile("s_waitcnt vmcnt(" #n ")" ::: "memory")
#define PG8_WAIT_L(n) asm volatile("s_waitcnt lgkmcnt(" #n ")" ::: "memory")
#define PG8_BAR __builtin_amdgcn_s_barrier()
#define PG8_SCHED __builtin_amdgcn_sched_barrier(0)
    Unit cur, nxt; int ui = 0;
    if (!S.next(0, cur)) return;
    f32x4 acc[2][2][4][2];
#pragma unroll
    for (int a = 0; a < 2; ++a)
#pragma unroll
        for (int b = 0; b < 2; ++b)
#pragma unroll
            for (int m = 0; m < 4; ++m)
#pragma unroll
                for (int n = 0; n < 2; ++n) acc[a][b][m][n] = (f32x4){0.f, 0.f, 0.f, 0.f};
    bf16x8 At[4][2], B0[2][2], B1[2][2];
    const char* cA = (const char*)g.A + (size_t)cur.pm * tstep; const char* cB = (const char*)g.Bt + (size_t)cur.pn * tstep;
    S.a_ready(cur);
    if constexpr (SP2) {
        PG8_STAGE(PG8_SB(0, 0), cB, voffB); PG8_STAGE(PG8_SB(0, 1), cB + hstep, voffB); PG8_STAGE(PG8_SA(0, 0), cA, voffA); PG8_STAGE(PG8_SA(0, 1), cA + hstep, voffA);
        if (wr == 1) PG8_BAR;
        PG8_WAIT_V(2); PG8_BAR;
        PG8_STAGE(PG8_SB(1, 0), cB + kstep, voffB); PG8_STAGE(PG8_SA(1, 0), cA + kstep, voffA); PG8_STAGE(PG8_SB(1, 1), cB + hstep + kstep, voffB);
        PG8_WAIT_V(6); PG8_BAR;
    } else {
        PG8_STAGE(PG8_SB(0, 0), cB, voffB); PG8_STAGE(PG8_SA(0, 0), cA, voffA); PG8_STAGE(PG8_SB(0, 1), cB + hstep, voffB); PG8_STAGE(PG8_SA(0, 1), cA + hstep, voffA);
        if (wr == 1) PG8_BAR;
        PG8_WAIT_V(4); PG8_BAR;
        PG8_STAGE(PG8_SB(1, 0), cB + kstep, voffB); PG8_STAGE(PG8_SA(1, 0), cA + kstep, voffA); PG8_STAGE(PG8_SB(1, 1), cB + hstep + kstep, voffB);
        PG8_WAIT_V(6); PG8_BAR;
    }
    for (;;) {
        const bool has_next = S.next(ui + 1, nxt);
        const char* nA = has_next ? (const char*)g.A + (size_t)nxt.pm * tstep : cA; const char* nB = has_next ? (const char*)g.Bt + (size_t)nxt.pn * tstep : cB;
        for (int t = 0; t < nt; t += 2) {
            const bool last = (t == nt - 2);
            const char* a1 = cA + (size_t)(t + 1) * kstep;
            const char* a2 = last ? nA : cA + (size_t)(t + 2) * kstep; const char* b2 = last ? nB : cB + (size_t)(t + 2) * kstep;
            const char* a3 = a2 + kstep; const char* b3 = b2 + kstep;
            if (last && has_next) S.a_ready(nxt);
            if constexpr (SP2) {
            PG8_LDB(B0, 0, 0); PG8_LDB(B1, 0, 1); PG8_SCHED; PG8_LDA(At, 0, 0); PG8_STAGE(PG8_SA(1, 1), a1 + hstep, voffA);
            PG8_WAIT_V(8); PG8_WAIT_L(0); PG8_BAR; PG8_MMA(0, 0, At, B0); PG8_MMA(0, 1, At, B1); PG8_BAR; PG8_SCHED;
            PG8_LDA(At, 0, 1); PG8_STAGE(PG8_SB(0, 0), b2, voffB); PG8_STAGE(PG8_SB(0, 1), b2 + hstep, voffB); PG8_STAGE(PG8_SA(0, 0), a2, voffA);
            PG8_WAIT_V(8); PG8_WAIT_L(0); PG8_BAR; PG8_MMA(1, 0, At, B0); PG8_MMA(1, 1, At, B1); PG8_BAR; PG8_SCHED;
            PG8_LDB(B0, 1, 0); PG8_LDB(B1, 1, 1); PG8_SCHED; PG8_LDA(At, 1, 0); PG8_STAGE(PG8_SA(0, 1), a2 + hstep, voffA);
            PG8_WAIT_V(8); PG8_WAIT_L(0); PG8_BAR; PG8_MMA(0, 0, At, B0); PG8_MMA(0, 1, At, B1); PG8_BAR; PG8_SCHED;
            PG8_LDA(At, 1, 1); PG8_STAGE(PG8_SB(1, 0), b3, voffB); PG8_STAGE(PG8_SB(1, 1), b3 + hstep, voffB); PG8_STAGE(PG8_SA(1, 0), a3, voffA);
            PG8_WAIT_V(8); PG8_WAIT_L(0); PG8_BAR; PG8_MMA(1, 0, At, B0); PG8_MMA(1, 1, At, B1); PG8_BAR; PG8_SCHED;
            } else {
            PG8_LDB(B0, 0, 0); PG8_SCHED; PG8_LDA(At, 0, 0); PG8_STAGE(PG8_SA(1, 1), a1 + hstep, voffA);
            PG8_WAIT_L(8); PG8_BAR; PG8_WAIT_L(0); PG8_MMA(0, 0, At, B0); PG8_BAR; PG8_SCHED;
            PG8_LDB(B1, 0, 1); PG8_STAGE(PG8_SB(0, 0), b2, voffB);
            PG8_BAR; PG8_WAIT_L(0); PG8_MMA(0, 1, At, B1); PG8_BAR;
            PG8_LDA(At, 0, 1); PG8_STAGE(PG8_SA(0, 0), a2, voffA);
            PG8_BAR; PG8_WAIT_L(0); PG8_MMA(1, 0, At, B0); PG8_BAR; PG8_SCHED;
            PG8_STAGE(PG8_SB(0, 1), b2 + hstep, voffB);
            PG8_WAIT_V(6); PG8_BAR; PG8_MMA(1, 1, At, B1); PG8_BAR;
            PG8_LDB(B0, 1, 0); PG8_SCHED; PG8_LDA(At, 1, 0); PG8_STAGE(PG8_SA(0, 1), a2 + hstep, voffA);
            PG8_WAIT_L(8); PG8_BAR; PG8_WAIT_L(0); PG8_MMA(0, 0, At, B0); PG8_BAR; PG8_SCHED;
            PG8_LDB(B1, 1, 1); PG8_STAGE(PG8_SB(1, 0), b3, voffB);
            PG8_BAR; PG8_WAIT_L(0); PG8_MMA(0, 1, At, B1); PG8_BAR;
            PG8_LDA(At, 1, 1); PG8_STAGE(PG8_SA(1, 0), a3, voffA);
            PG8_BAR; PG8_WAIT_L(0); PG8_MMA(1, 0, At, B0); PG8_BAR; PG8_SCHED;
            PG8_STAGE(PG8_SB(1, 1), b3 + hstep, voffB);
            PG8_WAIT_V(6); PG8_BAR; PG8_MMA(1, 1, At, B1); PG8_BAR;
            }
        }
        if constexpr (ALIGN_EPI) { if (wr == 0) PG8_BAR; }
        if constexpr (MT == 2) asm volatile("s_nop 15\n\ts_nop 15\n\ts_nop 15" ::: "memory");
        E(acc, cur, wr, wc, fr, fq);
        if (!has_next) break;
#pragma unroll
        for (int a = 0; a < 2; ++a)
#pragma unroll
            for (int b = 0; b < 2; ++b)
#pragma unroll
                for (int m = 0; m < 4; ++m)
#pragma unroll
                    for (int n = 0; n < 2; ++n) acc[a][b][m][n] = (f32x4){0.f, 0.f, 0.f, 0.f};
        cur = nxt; cA = nA; cB = nB; ++ui;
        if constexpr (ALIGN_EPI) { if (wr == 1) PG8_BAR; }
    }
    PG8_WAIT_V(0);
    if constexpr (!ALIGN_EPI) { if (wr == 0) PG8_BAR; }
    PG8_BAR;
#undef PG8_SA
#undef PG8_SB
#undef PG8_STAGE
#undef PG8_LDA
#undef PG8_LDB
#undef PG8_MMA
#undef PG8_WAIT_V
#undef PG8_WAIT_L
#undef PG8_BAR
#undef PG8_SCHED
}
}

constexpr int NWAVES = 8;
constexpr int BATCH = 2, SEQ = 8192, DM = 4096, M = BATCH * SEQ;
constexpr int HD = 128, NH = 16, DA = 2048, NIH = 32, IDIM = 64, DFF = 16384, TOPK = 256, CHUNK = 64, NCHUNK = SEQ / CHUNK;
constexpr int DIN = 22640, NPAD = 22784;
constexpr float EPS = 1e-6f;
constexpr float ATT_SCALE = 0.08838834764831845f;
constexpr float IW_SCALE = 0.125f * 0.17677669529663687f;
constexpr int SRC_QA = 0, SRC_KA = 2048, SRC_VA = 4096, SRC_IQ = 6144, SRC_IK = 8192, SRC_IW = 8256, SRC_QB = 8288, SRC_KB = 10336, SRC_VB = 12384, SRC_FL = 14432, SRC_GA = 14448, SRC_GB = 18544;
constexpr int DST_QKV = 0, DST_G = 12288, DST_IQ = 20480, DST_SP = 22528;
constexpr int TILE_G0 = DST_G / 256, TILE_IQ0 = DST_IQ / 256, TILE_SP = DST_SP / 256;

constexpr size_t MiB = 1u << 20;
constexpr size_t WS_CTL = 0, CTL_ZERO_BYTES = 64 * 1024;
constexpr size_t WS_MASK = 1 * MiB;
constexpr size_t WS_CUM = 17 * MiB;
constexpr size_t WS_MISC = 18 * MiB;
constexpr size_t WS_NORM = 19 * MiB;
constexpr size_t WS_CD = 20 * MiB;
constexpr size_t WS_WIN8 = WS_CD, WS_WINH = WS_CD + 80 * MiB, WS_XN8 = WS_CD + 98 * MiB, WS_XN = WS_CD + 162 * MiB, WS_SCORE = WS_CD, WS_WDN = WS_CD + 128 * MiB;
constexpr size_t WS_SSP = 280 * MiB, WS_RSTD = 284 * MiB;
constexpr size_t WS_B = 326 * MiB;
constexpr size_t WS_WOA = WS_B, WS_WOB = WS_B + 16 * MiB, WS_WO = WS_B + 32 * MiB;
constexpr size_t WS_E = 390 * MiB;
constexpr size_t ACT2K = 64 * MiB;
constexpr size_t WS_T = WS_E + 2 * ACT2K, WS_MERGED = WS_E + 4 * ACT2K;
constexpr size_t WS_F = 774 * MiB;
constexpr size_t WS_IQ = WS_F, WS_IK = WS_F + 64 * MiB, WS_IW = WS_F + 66 * MiB, WS_FL = WS_F + 68 * MiB;
constexpr size_t WS_H = WS_B;
constexpr size_t WS_G = 846 * MiB;
constexpr size_t WS_GA = WS_G, WS_GB = WS_G + 64 * MiB, WS_X2B = WS_G, WS_Y8A = WS_G + 128 * MiB, WS_Y8B = WS_G + 160 * MiB;
constexpr size_t WS_X1B = 1102 * MiB;
constexpr size_t WS_WUP = 1230 * MiB;
constexpr size_t WS_END = 1358 * MiB;
constexpr int UP_EARLY_PER_WAVE = 7;
static_assert(WS_H + (size_t)M * DFF * 2 <= WS_G && WS_F + 72 * MiB <= WS_G && WS_SCORE + 280 * MiB <= WS_B, "ws map");
constexpr int CW_TMO = 0, CW_BAR = 4096;
constexpr int CW_RSS1 = 16384, CW_RSS2 = 32768;

constexpr int RING_OFF = 0, RING_BYTES = 131072;
constexpr int LDSCTL_OFF = 143360, MISC_OFF = LDSCTL_OFF + 320;
constexpr int LDS_BYTES = 147456;

#define GAS __attribute__((address_space(1)))
#define LAS __attribute__((address_space(3)))
typedef unsigned short bf16;
typedef unsigned v4u __attribute__((ext_vector_type(4)));
typedef float f32x4 __attribute__((ext_vector_type(4)));
typedef float f32x16 __attribute__((ext_vector_type(16)));
typedef _Float16 f16x8 __attribute__((ext_vector_type(8)));
typedef GAS unsigned gu32;
#define RLX_AGENT __ATOMIC_RELAXED, __HIP_MEMORY_SCOPE_AGENT
#define LDS_WAIT() asm volatile("s_waitcnt lgkmcnt(0)" ::: "memory")
#define VM_WAIT() asm volatile("s_waitcnt vmcnt(0)" ::: "memory")
__device__ __forceinline__ unsigned f2bf(float f) { unsigned u = __builtin_bit_cast(unsigned, f); return (u + 0x7fffu + ((u >> 16) & 1u)) >> 16; }
__device__ __forceinline__ unsigned pk2bf(float lo, float hi) { return f2bf(lo) | (f2bf(hi) << 16); }
__device__ __forceinline__ unsigned pk2h(float lo, float hi) { return pg8::cvt_pk_f16(lo, hi); }
__device__ __forceinline__ float bf2f(bf16 b) { return __builtin_bit_cast(float, ((unsigned)b) << 16); }

#define XB_TMO      128
#define XB_XCNT(j)  (256  + 64 * (j))
#define XB_XSUB(j)  (1280 + 64 * (j))
#define XB_XGEN(j)  (2304 + 64 * (j))
#define XB_TOP      3328
#define XB_TOPGEN   3392
#define XCD_BAR_WORDS 3456
#define XB_SPIN_CAP (1u << 22)
__device__ __forceinline__ unsigned xb_ld(unsigned* p)              { return __hip_atomic_load(p, __ATOMIC_RELAXED, __HIP_MEMORY_SCOPE_AGENT); }
__device__ __forceinline__ unsigned xb_add(unsigned* p, unsigned v) { return __hip_atomic_fetch_add(p, v, __ATOMIC_RELAXED, __HIP_MEMORY_SCOPE_AGENT); }
__device__ __forceinline__ unsigned xb_xcc_id() { return (unsigned)__builtin_amdgcn_s_getreg((3 << 11) | 20) & 0xFu; }
#define XB_SPIN(cond, bar) do { unsigned _sp = 0; while (cond) { __builtin_amdgcn_s_sleep(1); \
    if ((++_sp & 255u) == 0u) { if (xb_ld(&(bar)[XB_TMO])) break; if (_sp > XB_SPIN_CAP) { atomicAdd(&(bar)[XB_TMO], 1u); break; } } } } while (0)
struct XcdBarrier { unsigned* bar; unsigned x; volatile LAS unsigned* st; };
__device__ __forceinline__ XcdBarrier xcd_barrier_post(unsigned* bar, volatile LAS unsigned* st) {
    XcdBarrier b; b.bar = bar; b.x = xb_xcc_id(); b.st = st;
    if (threadIdx.x == 0) (void)xb_add(&bar[XB_XCNT(b.x)], 1u);
    return b;
}
__device__ __forceinline__ void xcd_barrier_complete(unsigned* bar, unsigned x, unsigned& nloc, unsigned& nx) {
    const unsigned G = gridDim.x * gridDim.y * gridDim.z;
    unsigned sum, cnt, mine, sp = 0u;
    for (;;) {
        sum = 0u; cnt = 0u; mine = 0u;
#pragma unroll
        for (unsigned j = 0; j < 16; ++j) { const unsigned c = xb_ld(&bar[XB_XCNT(j)]); sum += c; cnt += (c > 0u) ? 1u : 0u; mine = (j == x) ? c : mine; }
        if (sum == G) break;
        __builtin_amdgcn_s_sleep(1);
        if ((++sp & 255u) == 0u) { if (xb_ld(&bar[XB_TMO])) break; if (sp > XB_SPIN_CAP) { atomicAdd(&bar[XB_TMO], 1u); break; } }
    }
    nloc = mine > 0u ? mine : 1u; nx = cnt > 0u ? cnt : 1u;
}
__device__ __forceinline__ void xcd_barrier(const XcdBarrier& b) {
    asm volatile("s_waitcnt vmcnt(0)" ::: "memory");
    __syncthreads();
    if (threadIdx.x == 0) {
        unsigned* bar = b.bar;
        __builtin_amdgcn_s_waitcnt(0);
        unsigned nloc = b.st[0], nx = b.st[1];
        if (nloc == 0u) { xcd_barrier_complete(bar, b.x, nloc, nx); b.st[0] = nloc; b.st[1] = nx; }
        const unsigned old = xb_add(&bar[XB_XSUB(b.x)], 1u);
        const unsigned gen = old / nloc;
        if (old + 1u == (gen + 1u) * nloc) {
            __builtin_amdgcn_fence(__ATOMIC_RELEASE, "agent");
            asm volatile("s_waitcnt vmcnt(0)" ::: "memory");
            const unsigned og = xb_add(&bar[XB_TOP], 1u);
            const unsigned tg = og / nx;
            if (og + 1u == (tg + 1u) * nx) xb_add(&bar[XB_TOPGEN], 1u);
            else XB_SPIN(xb_ld(&bar[XB_TOPGEN]) == tg, bar);
            __builtin_amdgcn_fence(__ATOMIC_ACQUIRE, "agent");
            xb_add(&bar[XB_XGEN(b.x)], 1u);
            asm volatile("s_waitcnt vmcnt(0)" ::: "memory");
        } else {
            XB_SPIN(xb_ld(&bar[XB_XGEN(b.x)]) == gen, bar);
            __builtin_amdgcn_fence(__ATOMIC_ACQUIRE, "agent");
            asm volatile("s_waitcnt vmcnt(0)" ::: "memory");
        }
    }
    __syncthreads();
}

struct Frame {
    LAS unsigned char* lds;
    volatile LAS unsigned* MISC;
    gu32* ctl;
    int tid, lane, wave, vcu, G;
    unsigned char* ws;
    const float *x, *w_in, *b_f, *w_out_a, *w_out_b, *w_o, *w_up, *w_down, *g_mix, *g_mlp, *g_final, *rel_bias;
    float* out;
};
__device__ __forceinline__ float wave_sum(float v) {
#pragma unroll
    for (int o = 1; o < 64; o <<= 1) v += __shfl_xor(v, o);
    return v;
}

template <bool F16>
__device__ __forceinline__ void transpose_item(const float* W, int K, int N, bf16* WT, int k0, int scol, int nvalid, int drow, const float* kscale, LAS float* scr, int lane) {
#pragma unroll 8
    for (int i = 0; i < 32; ++i) { const int kk = 2 * i + (lane >> 5); const int c = lane & 31;
        float v = (c < nvalid) ? W[(size_t)(k0 + kk) * N + scol + c] : 0.f; if (kscale) v *= kscale[k0 + kk]; scr[kk * 33 + c] = v; }
    LDS_WAIT(); asm volatile("" ::: "memory");
    const int c = lane & 7;
#pragma unroll
    for (int j = 0; j < 4; ++j) { const int n = (lane >> 3) + 8 * j; const LAS float* s = scr + (8 * c) * 33 + n;
        v4u o;
        if constexpr (F16) { o.x = pk2h(s[0 * 33], s[1 * 33]); o.y = pk2h(s[2 * 33], s[3 * 33]); o.z = pk2h(s[4 * 33], s[5 * 33]); o.w = pk2h(s[6 * 33], s[7 * 33]); }
        else { o.x = pk2bf(s[0 * 33], s[1 * 33]); o.y = pk2bf(s[2 * 33], s[3 * 33]); o.z = pk2bf(s[4 * 33], s[5 * 33]); o.w = pk2bf(s[6 * 33], s[7 * 33]); }
        *(GAS v4u*)(WT + (size_t)(drow + n) * K + k0 + 8 * c) = o; }
    LDS_WAIT(); asm volatile("" ::: "memory");
}
struct TpJob { const float* W; bf16* WT; int K, N, k0, scol, drow, f16; const float* ks; };
__device__ __forceinline__ void tp_load(const TpJob& J, f32x4 (&v)[16], int lane) {
    const float* p = J.W + (size_t)(J.k0 + (lane >> 4)) * J.N + J.scol + 4 * (lane & 15);
#pragma unroll
    for (int i = 0; i < 16; ++i) v[i] = *(const f32x4*)(p + (size_t)(4 * i) * J.N);
}
__device__ __forceinline__ void tp_store(const TpJob& J, const f32x4 (&v)[16], LAS float* scr, int lane) {
    { LAS float* d = scr + (lane >> 4) * 65 + 4 * (lane & 15);
#pragma unroll
      for (int i = 0; i < 16; ++i) { d[(4 * i) * 65 + 0] = v[i][0]; d[(4 * i) * 65 + 1] = v[i][1]; d[(4 * i) * 65 + 2] = v[i][2]; d[(4 * i) * 65 + 3] = v[i][3]; } }
    LDS_WAIT(); asm volatile("" ::: "memory");
    const int nl = lane >> 3, kc = lane & 7;
#pragma unroll
    for (int j = 0; j < 8; ++j) { const int n = nl + 8 * j; const LAS float* q = scr + (8 * kc) * 65 + n;
        v4u o;
        if (J.f16 == 1) { o.x = pk2h(q[0 * 65], q[1 * 65]); o.y = pk2h(q[2 * 65], q[3 * 65]); o.z = pk2h(q[4 * 65], q[5 * 65]); o.w = pk2h(q[6 * 65], q[7 * 65]); }
        else if (J.ks) { const f32x4 s0 = *(const f32x4*)(J.ks + J.k0 + 8 * kc), s1 = *(const f32x4*)(J.ks + J.k0 + 8 * kc + 4);
            o.x = pg8::cvt_pk_bf16(q[0 * 65] * s0[0], q[1 * 65] * s0[1]); o.y = pg8::cvt_pk_bf16(q[2 * 65] * s0[2], q[3 * 65] * s0[3]); o.z = pg8::cvt_pk_bf16(q[4 * 65] * s1[0], q[5 * 65] * s1[1]); o.w = pg8::cvt_pk_bf16(q[6 * 65] * s1[2], q[7 * 65] * s1[3]); }
        else { o.x = pg8::cvt_pk_bf16(q[0 * 65], q[1 * 65]); o.y = pg8::cvt_pk_bf16(q[2 * 65], q[3 * 65]); o.z = pg8::cvt_pk_bf16(q[4 * 65], q[5 * 65]); o.w = pg8::cvt_pk_bf16(q[6 * 65], q[7 * 65]); }
        if (J.f16 == 2) {
            int p0 = __builtin_amdgcn_cvt_pk_fp8_f32(q[0 * 65] * 64.f, q[1 * 65] * 64.f, 0, false); p0 = __builtin_amdgcn_cvt_pk_fp8_f32(q[2 * 65] * 64.f, q[3 * 65] * 64.f, p0, true);
            int p1 = __builtin_amdgcn_cvt_pk_fp8_f32(q[4 * 65] * 64.f, q[5 * 65] * 64.f, 0, false); p1 = __builtin_amdgcn_cvt_pk_fp8_f32(q[6 * 65] * 64.f, q[7 * 65] * 64.f, p1, true);
            *(GAS unsigned long long*)((GAS unsigned char*)J.WT + (size_t)(J.drow + n) * J.K + J.k0 + 8 * kc) = (unsigned long long)(unsigned)p0 | ((unsigned long long)(unsigned)p1 << 32); }
        else *(GAS v4u*)(J.WT + (size_t)(J.drow + n) * J.K + J.k0 + 8 * kc) = o; }
    LDS_WAIT(); asm volatile("" ::: "memory");
}
template <class Decode>
__device__ __forceinline__ void tp_run(Frame& F, int nitems, const Decode& dec, int gw, int NGW) {
    LAS float* scr = (LAS float*)(F.lds + RING_OFF + F.wave * 16640);
    f32x4 va[16], vb[16]; TpJob ja, jb;
    int it = gw; if (it >= nitems) return;
    ja = dec(it); tp_load(ja, va, F.lane);
    for (;;) {
        const int i1 = it + NGW; const bool h1 = i1 < nitems;
        if (h1) { jb = dec(i1); tp_load(jb, vb, F.lane); }
        tp_store(ja, va, scr, F.lane);
        if (!h1) break;
        const int i2 = i1 + NGW; const bool h2 = i2 < nitems;
        if (h2) { ja = dec(i2); tp_load(ja, va, F.lane); }
        tp_store(jb, vb, scr, F.lane);
        if (!h2) break;
        it = i2;
    }
}
__device__ __forceinline__ void win_group(int gi, int& scol, int& nvalid) {
    const int d = gi * 32; nvalid = 32;
    if (d < DST_G) { const int t = d / 2048, o = d % 2048; const int base = (t == 0) ? SRC_QA : (t == 1) ? SRC_QB : (t == 2) ? SRC_KA : (t == 3) ? SRC_VA : (t == 4) ? SRC_KB : SRC_VB; scol = base + o; }
    else if (d < DST_IQ) { const int o = d - DST_G; scol = (o < 4096) ? SRC_GA + o : SRC_GB + (o - 4096); }
    else if (d < DST_SP) { scol = SRC_IQ + (d - DST_IQ); }
    else { const int o = d - DST_SP; if (o < 64) scol = SRC_IK + o; else if (o < 96) scol = SRC_IW + (o - 64); else if (o < 128) { scol = SRC_FL; nvalid = 16; } else { scol = 0; nvalid = 0; } }
}
__device__ __forceinline__ void p0_prologue(Frame& F) {
    const int gw = F.vcu * NWAVES + F.wave, NGW = F.G * NWAVES;
    constexpr int G8 = DST_IQ / 64, GH = (DST_SP - DST_IQ) / 64 + 1;
    constexpr int I8 = (DM / 64) * G8, IH = (DM / 64) * GH;
    const float* w_in = F.w_in; unsigned char* ws = F.ws;
    tp_run(F, I8 + IH, [=](int r) {
        TpJob J; int scol, nv;
        if (r < I8) { const int gi = r % G8, kb = r / G8; win_group(2 * gi, scol, nv); J = TpJob{w_in, (bf16*)(ws + WS_WIN8), DM, DIN, 64 * kb, scol, 64 * gi, 2, nullptr}; return J; } r -= I8;
        { const int gi = r % GH, kb = r / GH; win_group(2 * (G8 + gi), scol, nv); J = TpJob{w_in, (bf16*)(ws + WS_WINH), DM, DIN, 64 * kb, scol, 64 * gi, 1, nullptr}; return J; }
    }, gw, NGW);
    { LAS float* scr = (LAS float*)(F.lds + RING_OFF + F.wave * 16640);
      for (int it = gw; it < 6 * (DM / 64); it += NGW) { const int gi = (DST_SP + 64) / 32 + it % 6, kb = it / 6; int scol, nv; win_group(gi, scol, nv);
          transpose_item<true>(F.w_in, DM, DIN, (bf16*)(F.ws + WS_WINH), 64 * kb, scol, nv, gi * 32 - DST_IQ, nullptr, scr, F.lane); } }
    for (int m = gw; m < M; m += NGW) {
        const GAS f32x4* xr = (const GAS f32x4*)(F.x + (size_t)m * DM) + F.lane;
        f32x4 v[16]; float s = 0.f;
#pragma unroll
        for (int j = 0; j < 16; ++j) { v[j] = xr[64 * j]; s += (v[j].x * v[j].x + v[j].y * v[j].y) + (v[j].z * v[j].z + v[j].w * v[j].w); }
        const float rstd = 1.0f / sqrtf(wave_sum(s) * (1.f / DM) + EPS);
        GAS unsigned long long* o8 = (GAS unsigned long long*)((bf16*)(F.ws + WS_XN) + (size_t)m * DM) + F.lane;
        const GAS f32x4* gr = (const GAS f32x4*)F.g_mix + F.lane;
        GAS unsigned* o4 = (GAS unsigned*)(F.ws + WS_XN8 + (size_t)m * DM) + F.lane;
#pragma unroll
        for (int j = 0; j < 16; ++j) { const f32x4 g = gr[64 * j];
            const float y0 = v[j].x * rstd * g.x, y1 = v[j].y * rstd * g.y, y2 = v[j].z * rstd * g.z, y3 = v[j].w * rstd * g.w;
            o8[64 * j] = (unsigned long long)pk2h(y0, y1) | ((unsigned long long)pk2h(y2, y3) << 32);
            int p8 = __builtin_amdgcn_cvt_pk_fp8_f32(y0, y1, 0, false); p8 = __builtin_amdgcn_cvt_pk_fp8_f32(y2, y3, p8, true);
            o4[64 * j] = (unsigned)p8; }
    }
}
__device__ __forceinline__ void p1_convert_small_weights(Frame& F, int widx, int nwg) {
    constexpr int I_OA = (DA / 64) * (DM / 64), I_O = (DM / 64) * (DM / 64);
    const float* w_oa = F.w_out_a; const float* w_ob = F.w_out_b; const float* w_o = F.w_o; unsigned char* ws = F.ws;
    tp_run(F, 2 * I_OA + I_O, [=](int r) {
        TpJob J;
        if (r < I_OA) { const int nb = r % (DM / 64), kb = r / (DM / 64); J = TpJob{w_oa, (bf16*)(ws + WS_WOA), DA, DM, 64 * kb, 64 * nb, 64 * nb, 2, nullptr}; return J; } r -= I_OA;
        if (r < I_OA) { const int nb = r % (DM / 64), kb = r / (DM / 64); J = TpJob{w_ob, (bf16*)(ws + WS_WOB), DA, DM, 64 * kb, 64 * nb, 64 * nb, 2, nullptr}; return J; } r -= I_OA;
        { const int nb = r % (DM / 64), kb = r / (DM / 64); J = TpJob{w_o, (bf16*)(ws + WS_WO), DM, DM, 64 * kb, 64 * nb, 64 * nb, 2, nullptr}; return J; }
    }, widx * NWAVES + F.wave, nwg * NWAVES);
    { constexpr int I_UP = (DM / 64) * (DFF / 64); const int nearly = UP_EARLY_PER_WAVE * nwg * NWAVES, up_early = nearly < I_UP ? nearly : I_UP;
      const float* w_up = F.w_up; const float* gml = F.g_mlp;
      tp_run(F, up_early, [=](int r) { const int nb = r % (DFF / 64), kb = r / (DFF / 64); TpJob J{w_up, (bf16*)(ws + WS_WUP), DM, DFF, 64 * kb, 64 * nb, 64 * nb, 0, gml}; return J; }, widx * NWAVES + F.wave, nwg * NWAVES); }
}
__device__ __forceinline__ void p5_convert_mlp_weights(Frame& F, int up_early) {
    constexpr int I_UP = (DM / 64) * (DFF / 64), I_DN = (DFF / 64) * (DM / 64);
    const float* w_up = F.w_up; const float* w_dn = F.w_down; const float* gml = F.g_mlp; unsigned char* ws = F.ws;
    const int n_up = I_UP - up_early;
    tp_run(F, n_up + I_DN, [=](int r) {
        TpJob J;
        if (r < n_up) { const int q = r + up_early, nb = q % (DFF / 64), kb = q / (DFF / 64); J = TpJob{w_up, (bf16*)(ws + WS_WUP), DM, DFF, 64 * kb, 64 * nb, 64 * nb, 0, gml}; return J; } r -= n_up;
        { const int nb = r % (DM / 64), kb = r / (DM / 64); J = TpJob{w_dn, (bf16*)(ws + WS_WDN), DFF, DM, 64 * kb, 64 * nb, 64 * nb, 0, nullptr}; return J; }
    }, F.vcu * NWAVES + F.wave, F.G * NWAVES);
}

using pg8::f32x2; using pg8::u32x4; using pg8::Unit;
__device__ __forceinline__ float sigmoidf_fast(float x) { return __builtin_amdgcn_rcpf(1.0f + __expf(-x)); }
template <int PART  > struct EpiInProj {
    static constexpr bool PERM = true;
    unsigned char* ws; const float* b_f; int pn_off; float scale;
    __device__ __forceinline__ void operator()(const f32x4 (&acc)[2][2][4][2], const Unit& u, int wr, int wc, int fr, int fq) const {
        int row0 = u.pm * 256 + wr * 64 + fr; asm volatile("" : "+v"(row0));
        const int c8 = wc * 32 + 8 * fq, pn = u.pn + pn_off; const float sc = scale;
        if (PART == 0 && pn < TILE_G0 && ((pn >> 3) == 0 || (pn >> 3) == 2 || (pn >> 3) == 3)) {
            unsigned char* base = ws + WS_E + (size_t)(pn >> 3) * ACT2K + (pn & 7) * 256 + c8;
#pragma unroll
            for (int ai = 0; ai < 2; ++ai)
#pragma unroll
                for (int m = 0; m < 4; ++m) { unsigned char* rowp = base + (size_t)(row0 + ai * 128 + m * 16) * DA;
#pragma unroll
                    for (int bj = 0; bj < 2; ++bj) { const f32x4 v0 = acc[ai][bj][m][0] * sc, v1 = acc[ai][bj][m][1] * sc;
                        int p0 = __builtin_amdgcn_cvt_pk_fp8_f32(v0[0], v0[1], 0, false); p0 = __builtin_amdgcn_cvt_pk_fp8_f32(v0[2], v0[3], p0, true);
                        int p1 = __builtin_amdgcn_cvt_pk_fp8_f32(v1[0], v1[1], 0, false); p1 = __builtin_amdgcn_cvt_pk_fp8_f32(v1[2], v1[3], p1, true);
                        pg8::u32x2 w2; w2.x = (unsigned)p0; w2.y = (unsigned)p1; *(pg8::u32x2*)(rowp + bj * 128) = w2; } }
        } else if (PART == 0 && pn < TILE_G0) {
            bf16* base = (bf16*)(ws + WS_E) + (size_t)(pn >> 3) * ((size_t)M * DA) + (pn & 7) * 256 + c8;
#pragma unroll
            for (int ai = 0; ai < 2; ++ai)
#pragma unroll
                for (int m = 0; m < 4; ++m) { bf16* rowp = base + (size_t)(row0 + ai * 128 + m * 16) * DA;
#pragma unroll
                    for (int bj = 0; bj < 2; ++bj) { const f32x4 v0 = acc[ai][bj][m][0] * sc, v1 = acc[ai][bj][m][1] * sc;
                        u32x4 w; w.x = pg8::cvt_pk_bf16(v0[0], v0[1]); w.y = pg8::cvt_pk_bf16(v0[2], v0[3]); w.z = pg8::cvt_pk_bf16(v1[0], v1[1]); w.w = pg8::cvt_pk_bf16(v1[2], v1[3]);
                        *(u32x4*)(rowp + bj * 128) = w; } }
        } else if (PART == 0) {
            const int t = pn - TILE_G0;
            unsigned char* base = ws + WS_GA + (size_t)(t >> 4) * ((size_t)M * DM) + (t & 15) * 256 + c8;
#pragma unroll
            for (int ai = 0; ai < 2; ++ai)
#pragma unroll
                for (int m = 0; m < 4; ++m) { unsigned char* rowp = base + (size_t)(row0 + ai * 128 + m * 16) * DM;
#pragma unroll
                    for (int bj = 0; bj < 2; ++bj) { const f32x4 v0 = acc[ai][bj][m][0] * sc, v1 = acc[ai][bj][m][1] * sc;
                        unsigned p0 = __builtin_amdgcn_cvt_pk_u8_f32(sigmoidf_fast(v0[0]) * 255.f, 0, 0u); p0 = __builtin_amdgcn_cvt_pk_u8_f32(sigmoidf_fast(v0[1]) * 255.f, 1, p0);
                        p0 = __builtin_amdgcn_cvt_pk_u8_f32(sigmoidf_fast(v0[2]) * 255.f, 2, p0); p0 = __builtin_amdgcn_cvt_pk_u8_f32(sigmoidf_fast(v0[3]) * 255.f, 3, p0);
                        unsigned p1 = __builtin_amdgcn_cvt_pk_u8_f32(sigmoidf_fast(v1[0]) * 255.f, 0, 0u); p1 = __builtin_amdgcn_cvt_pk_u8_f32(sigmoidf_fast(v1[1]) * 255.f, 1, p1);
                        p1 = __builtin_amdgcn_cvt_pk_u8_f32(sigmoidf_fast(v1[2]) * 255.f, 2, p1); p1 = __builtin_amdgcn_cvt_pk_u8_f32(sigmoidf_fast(v1[3]) * 255.f, 3, p1);
                        pg8::u32x2 w2; w2.x = p0; w2.y = p1; *(pg8::u32x2*)(rowp + bj * 128) = w2; } }
        } else if (PART == 1 && pn < TILE_SP) {
            bf16* base = (bf16*)(ws + WS_IQ);
#pragma unroll
            for (int ai = 0; ai < 2; ++ai)
#pragma unroll
                for (int m = 0; m < 4; ++m) { bf16* rowp = base + (size_t)(row0 + ai * 128 + m * 16) * 2048;
#pragma unroll
                    for (int bj = 0; bj < 2; ++bj) { const f32x4 v0 = acc[ai][bj][m][0], v1 = acc[ai][bj][m][1];
                        const int col = (pn - TILE_IQ0) * 256 + bj * 128 + c8, hh = col >> 6, d0 = col & 63;
                        u32x4 w; w.x = pk2h(v0[0], v0[1]); w.y = pk2h(v0[2], v0[3]); w.z = pk2h(v1[0], v1[1]); w.w = pk2h(v1[2], v1[3]);
                        *(u32x4*)(rowp + (d0 >> 4) * 512 + (((d0 >> 3) & 1) * 32 + hh) * 8) = w; } }
        } else if (PART == 1) {
#pragma unroll
            for (int ai = 0; ai < 2; ++ai)
#pragma unroll
                for (int m = 0; m < 4; ++m) { const size_t r = (size_t)(row0 + ai * 128 + m * 16); const f32x4 v0 = acc[ai][0][m][0], v1 = acc[ai][0][m][1];
                    if (c8 < 64) { u32x4 w; w.x = pk2h(v0[0], v0[1]); w.y = pk2h(v0[2], v0[3]); w.z = pk2h(v1[0], v1[1]); w.w = pk2h(v1[2], v1[3]); *(u32x4*)((bf16*)(ws + WS_IK) + (r >> 5) * 2048 + (c8 >> 4) * 512 + (((c8 >> 3) & 1) * 32 + (r & 31)) * 8) = w; }
                    else if (c8 < 96) { float* p = (float*)(ws + WS_IW) + r * 32 + (c8 - 64); *(f32x4*)p = v0 * IW_SCALE; *(f32x4*)(p + 4) = v1 * IW_SCALE; }
                    else if (c8 < 112) { float* p = (float*)(ws + WS_FL) + r * 16 + (c8 - 96); f32x4 o0, o1;
#pragma unroll
                        for (int j = 0; j < 4; ++j) { const float a = v0[j] + b_f[c8 - 96 + j], b = v1[j] + b_f[c8 - 96 + 4 + j];
                            o0[j] = fminf(a, 0.f) - log1pf(expf(-fabsf(a))); o1[j] = fminf(b, 0.f) - log1pf(expf(-fabsf(b))); }
                        *(f32x4*)p = o0; *(f32x4*)(p + 4) = o1; } }
        }
    }
};
template <bool SECOND> struct EpiGate {
    static constexpr bool PERM = true;
    const unsigned char* gate; bf16* T; bf16* out; float sc;
    __device__ __forceinline__ void operator()(const f32x4 (&acc)[2][2][4][2], const Unit& u, int wr, int wc, int fr, int fq) const {
        const int row0 = u.pm * 256 + wr * 64 + fr, col0 = u.pn * 256 + wc * 32 + 8 * fq;
#pragma unroll
        for (int ai = 0; ai < 2; ++ai)
#pragma unroll
            for (int m = 0; m < 4; ++m) { const size_t ro = (size_t)(row0 + ai * 128 + m * 16) * DM + col0;
#pragma unroll
                for (int bj = 0; bj < 2; ++bj) { const f32x4 v0 = acc[ai][bj][m][0], v1 = acc[ai][bj][m][1];
                    const pg8::u32x2 gv = *(const pg8::u32x2*)(gate + ro + bj * 128); const float c255 = sc * (1.0f / 255.0f);
                    float r[8] = { v0[0] * ((float)(gv.x & 0xffu) * c255), v0[1] * ((float)((gv.x >> 8) & 0xffu) * c255), v0[2] * ((float)((gv.x >> 16) & 0xffu) * c255), v0[3] * ((float)(gv.x >> 24) * c255),
                                   v1[0] * ((float)(gv.y & 0xffu) * c255), v1[1] * ((float)((gv.y >> 8) & 0xffu) * c255), v1[2] * ((float)((gv.y >> 16) & 0xffu) * c255), v1[3] * ((float)(gv.y >> 24) * c255) };
                    if constexpr (SECOND) { const u32x4 tv = *(const u32x4*)(T + ro + bj * 128);
                        r[0] += pg8::bf_lo(tv.x); r[1] += pg8::bf_hi(tv.x); r[2] += pg8::bf_lo(tv.y); r[3] += pg8::bf_hi(tv.y); r[4] += pg8::bf_lo(tv.z); r[5] += pg8::bf_hi(tv.z); r[6] += pg8::bf_lo(tv.w); r[7] += pg8::bf_hi(tv.w); }
                    if constexpr (SECOND) {
                        int p0 = __builtin_amdgcn_cvt_pk_fp8_f32(r[0] * 16.f, r[1] * 16.f, 0, false); p0 = __builtin_amdgcn_cvt_pk_fp8_f32(r[2] * 16.f, r[3] * 16.f, p0, true);
                        int p1 = __builtin_amdgcn_cvt_pk_fp8_f32(r[4] * 16.f, r[5] * 16.f, 0, false); p1 = __builtin_amdgcn_cvt_pk_fp8_f32(r[6] * 16.f, r[7] * 16.f, p1, true);
                        pg8::u32x2 w2; w2.x = (unsigned)p0; w2.y = (unsigned)p1; *(pg8::u32x2*)((unsigned char*)out + ro + bj * 128) = w2; }
                    else { u32x4 w; w.x = pg8::cvt_pk_bf16(r[0], r[1]); w.y = pg8::cvt_pk_bf16(r[2], r[3]); w.z = pg8::cvt_pk_bf16(r[4], r[5]); w.w = pg8::cvt_pk_bf16(r[6], r[7]);
                        *(u32x4*)(out + ro + bj * 128) = w; } }
                asm volatile("" ::: "memory"); }
    }
};
struct EpiResid {
    static constexpr bool PERM = true;
    const bf16* base; bf16* out;
    __device__ __forceinline__ void operator()(const f32x4 (&acc)[2][2][4][2], const Unit& u, int wr, int wc, int fr, int fq) const {
        const int row0 = u.pm * 256 + wr * 64 + fr, col0 = u.pn * 256 + wc * 32 + 8 * fq;
#pragma unroll
        for (int ai = 0; ai < 2; ++ai)
#pragma unroll
            for (int m = 0; m < 4; ++m) { const int row = row0 + ai * 128 + m * 16; const size_t ro = (size_t)row * DM + col0;
#pragma unroll
                for (int bj = 0; bj < 2; ++bj) { const u32x4 bv = *(const u32x4*)(base + ro + bj * 128); const f32x4 v0 = acc[ai][bj][m][0], v1 = acc[ai][bj][m][1];
                    u32x4 w; w.x = pg8::cvt_pk_bf16(v0[0] + pg8::bf_lo(bv.x), v0[1] + pg8::bf_hi(bv.x)); w.y = pg8::cvt_pk_bf16(v0[2] + pg8::bf_lo(bv.y), v0[3] + pg8::bf_hi(bv.y));
                    w.z = pg8::cvt_pk_bf16(v1[0] + pg8::bf_lo(bv.z), v1[1] + pg8::bf_hi(bv.z)); w.w = pg8::cvt_pk_bf16(v1[2] + pg8::bf_lo(bv.w), v1[3] + pg8::bf_hi(bv.w));
                    *(u32x4*)(out + ro + bj * 128) = w; }
                asm volatile("" ::: "memory"); }
    }
};
struct EpiResidNorm {
    static constexpr bool PERM = true;
    const float* base; bf16* xb; float* ss; float sc;
    __device__ __forceinline__ void operator()(const f32x4 (&acc)[2][2][4][2], const Unit& u, int wr, int wc, int fr, int fq) const {
        const int row0 = u.pm * 256 + wr * 64 + fr, col0 = u.pn * 256 + wc * 32 + 8 * fq;
#pragma unroll
        for (int ai = 0; ai < 2; ++ai)
#pragma unroll
            for (int m = 0; m < 4; ++m) { const int row = row0 + ai * 128 + m * 16; const size_t ro = (size_t)row * DM + col0; float q = 0.f;
#pragma unroll
                for (int bj = 0; bj < 2; ++bj) { const f32x4 b0 = *(const f32x4*)(base + ro + bj * 128), b1 = *(const f32x4*)(base + ro + bj * 128 + 4);
                    const f32x4 y0 = acc[ai][bj][m][0] * sc + b0, y1 = acc[ai][bj][m][1] * sc + b1;
                    u32x4 w; w.x = pg8::cvt_pk_bf16(y0[0], y0[1]); w.y = pg8::cvt_pk_bf16(y0[2], y0[3]); w.z = pg8::cvt_pk_bf16(y1[0], y1[1]); w.w = pg8::cvt_pk_bf16(y1[2], y1[3]);
                    *(u32x4*)(xb + ro + bj * 128) = w;
                    q += ((y0[0] * y0[0] + y0[1] * y0[1]) + (y0[2] * y0[2] + y0[3] * y0[3])) + ((y1[0] * y1[0] + y1[1] * y1[1]) + (y1[2] * y1[2] + y1[3] * y1[3])); }
                q += __shfl_xor(q, 16); q += __shfl_xor(q, 32);
                if (fq == 0) ss[(size_t)(4 * u.pn + wc) * M + row] = q;
                asm volatile("" ::: "memory"); }
    }
};
constexpr int RSTD_LDS_OFF = 135168;
struct EpiUp {
    static constexpr bool PERM = true;
    bf16* H; const float* ss; LAS float* rl; mutable int cpm;
    __device__ __forceinline__ void operator()(const f32x4 (&acc)[2][2][4][2], const Unit& u, int wr, int wc, int fr, int fq) const {
        if (u.pm != cpm) {
            __syncthreads();
            int t_ = threadIdx.x; asm volatile("" : "+v"(t_));
            const int prow = t_ >> 1, half = t_ & 1; const float* sp = ss + (size_t)(32 * half) * M + u.pm * 256 + prow; float q = 0.f;
#pragma unroll 8
            for (int i = 0; i < 32; ++i) q += sp[(size_t)i * M];
            q += __shfl_xor(q, 1);
            if (half == 0) rl[prow] = 1.0f / sqrtf(q * (1.f / DM) + EPS);
            __syncthreads();
            cpm = u.pm;
        }
        const int row0 = u.pm * 256 + wr * 64 + fr, col0 = u.pn * 256 + wc * 32 + 8 * fq;
#pragma unroll
        for (int ai = 0; ai < 2; ++ai)
#pragma unroll
            for (int m = 0; m < 4; ++m) { const int row = row0 + ai * 128 + m * 16; bf16* rowp = H + (size_t)row * DFF + col0; const float rs = rl[row & 255];
#pragma unroll
                for (int bj = 0; bj < 2; ++bj) { f32x4 v0 = acc[ai][bj][m][0] * rs, v1 = acc[ai][bj][m][1] * rs;
#pragma unroll
                    for (int j = 0; j < 4; ++j) { const float a = fmaxf(v0[j], 0.f), b = fmaxf(v1[j], 0.f); v0[j] = a * a; v1[j] = b * b; }
                    u32x4 w; w.x = pg8::cvt_pk_bf16(v0[0], v0[1]); w.y = pg8::cvt_pk_bf16(v0[2], v0[3]); w.z = pg8::cvt_pk_bf16(v1[0], v1[1]); w.w = pg8::cvt_pk_bf16(v1[2], v1[3]);
                    *(u32x4*)(rowp + bj * 128) = w; } }
    }
};

__device__ __forceinline__ float relu_bits(float x) { const int i = __builtin_bit_cast(int, x); return __builtin_bit_cast(float, i > 0 ? i : 0); }
constexpr int SC_PAD = 320;
constexpr size_t SC_PERB = (size_t)4096 * (NCHUNK * (NCHUNK + 1) / 2) + (size_t)64 * SC_PAD * NCHUNK;
__device__ __forceinline__ size_t score_off(int b, int c) { return (size_t)b * SC_PERB + (size_t)4096 * ((size_t)c * (c + 1) / 2) + (size_t)64 * SC_PAD * c; }
__device__ __forceinline__ void p2_scores(Frame& F) {
    const int gw = F.vcu * NWAVES + F.wave, NGW = F.G * NWAVES, lane = F.lane, r = lane & 31, hi = lane >> 5;
    if (gw < BATCH * NH) {
        const int b = gw / NH, h = gw % NH; const float* fl = (const float*)(F.ws + WS_FL) + (size_t)b * SEQ * 16 + h; float* cum = (float*)(F.ws + WS_CUM) + (size_t)(b * NH + h) * SEQ;
        float vals[128];
#pragma unroll
        for (int i = 0; i < 128; ++i) vals[i] = fl[(size_t)(128 * lane + i) * 16];
        float run = 0.f;
#pragma unroll
        for (int i = 0; i < 128; ++i) { run += vals[i]; vals[i] = run; }
        float incl = run;
#pragma unroll
        for (int o = 1; o < 64; o <<= 1) { const float t = __shfl_up(incl, o); if (lane >= o) incl += t; }
        const float off = incl - run;
#pragma unroll
        for (int i = 0; i < 128; i += 4) *(f32x4*)(cum + 128 * lane + i) = (f32x4){vals[i] + off, vals[i + 1] + off, vals[i + 2] + off, vals[i + 3] + off};
    }
    {
        const bf16* QBp = (const bf16*)(F.ws + WS_E) + (size_t)M * DA; const bf16* KBp = (const bf16*)(F.ws + WS_E) + 4 * (size_t)M * DA;
        float* nrm = (float*)(F.ws + WS_NORM);
        for (int it = gw; it < 2 * BATCH * NH * 128; it += NGW) {
            const int which = it & 1, tile = (it >> 1) & 127, bh = it >> 8, b = bh >> 4, h = bh & 15;
            const bf16* src = (which ? QBp : KBp) + ((size_t)b * SEQ + tile * 64 + lane) * DA + h * HD;
            float ss = 0.f;
#pragma unroll
            for (int i = 0; i < 16; ++i) { const u32x4 w = *(const u32x4*)(src + 8 * i);
                const float a0 = pg8::bf_lo(w.x), a1 = pg8::bf_hi(w.x), a2 = pg8::bf_lo(w.y), a3 = pg8::bf_hi(w.y), a4 = pg8::bf_lo(w.z), a5 = pg8::bf_hi(w.z), a6 = pg8::bf_lo(w.w), a7 = pg8::bf_hi(w.w);
                ss += (a0 * a0 + a1 * a1) + (a2 * a2 + a3 * a3) + (a4 * a4 + a5 * a5) + (a6 * a6 + a7 * a7); }
#pragma unroll
            for (int o = 1; o < 64; o <<= 1) ss = fmaxf(ss, __shfl_xor(ss, o));
            if (lane == 0) nrm[(size_t)(which * BATCH * NH + bh) * 128 + tile] = sqrtf(ss) * 1.001f;
        }
    }
}
__device__ __forceinline__ unsigned sortable(float f) { const unsigned u = __builtin_bit_cast(unsigned, f); return u ^ ((u >> 31) ? 0xFFFFFFFFu : 0x80000000u); }
__device__ __forceinline__ void select_regs(Frame& F, int row, unsigned (&v)[128]);
__device__ __forceinline__ void p2_index_select(Frame& F) {
    const int lane = F.lane, r = lane & 31, hi = lane >> 5, wave = F.wave;
    const bf16* IQ = (const bf16*)(F.ws + WS_IQ); const bf16* IK = (const bf16*)(F.ws + WS_IK); const float* IW = (const float*)(F.ws + WS_IW); float* SC = (float*)(F.ws + WS_SCORE);
    float* dummy = (float*)(F.ws + WS_MISC) + (size_t)(F.vcu * NWAVES + wave) * 64;
    LAS unsigned char* tl = F.lds + RING_OFF;
    for (int wu = blockIdx.x; wu < 2048; wu += F.G) {
        const int w = wu & 255, i8 = wu >> 8, p = w & 63, b = (w >> 6) & 1, c = (i8 & 1) ? 127 - p : p, qg = 4 * (w >> 7) + (i8 >> 1);
        const int limit = 64 * (c + 1), ntile = (limit + 127) >> 7;
        const size_t row = (size_t)b * SEQ + 64 * c + 8 * qg + wave;
        f32x4 wv[4];
        LAS unsigned char* asl = tl + 6 * 16384 + wave * 4096 + lane * 16;
        { f16x8 a_[4];
#pragma unroll
          for (int st = 0; st < 4; ++st) a_[st] = *(const f16x8*)(IQ + row * 2048 + 512 * st + lane * 8);
#pragma unroll
          for (int st = 0; st < 4; ++st) *(LAS f16x8*)(asl + st * 1024) = a_[st]; }
#pragma unroll
        for (int g4 = 0; g4 < 4; ++g4) wv[g4] = *(const f32x4*)(IW + row * 32 + 8 * g4 + 4 * hi);
        const char* ikb = (const char*)(IK + ((size_t)b * SEQ / 32) * 2048);
        unsigned v[128];
#pragma unroll
        for (int i = 0; i < 128; ++i) v[i] = 0u;
#define IDX_STAGE(t_, b_) do { const int tt_ = (t_) < ntile ? (t_) : ntile - 1; _Pragma("unroll") for (int i_ = 0; i_ < 2; ++i_) \
            __builtin_amdgcn_global_load_lds((const unsigned*)(ikb + (size_t)tt_ * 16384 + i_ * 8192 + wave * 1024 + lane * 16), (LAS unsigned*)(tl + (b_) * 16384 + i_ * 8192 + wave * 1024), 16, 0, 0); } while (0)
        IDX_STAGE(0, 0); IDX_STAGE(1, 1); IDX_STAGE(2, 2); IDX_STAGE(3, 3); IDX_STAGE(4, 4);
        asm volatile("s_waitcnt vmcnt(8)" ::: "memory"); asm volatile("s_waitcnt lgkmcnt(0)" ::: "memory"); __builtin_amdgcn_s_barrier(); asm volatile("" ::: "memory");
        for (int g6 = 0; 6 * g6 < ntile; ++g6) {
#pragma unroll
            for (int u = 0; u < 6; ++u) {
                const int t = 6 * g6 + u;
                if (t < ntile) {
                    IDX_STAGE(t + 5, (u + 5) % 6);
                    const LAS unsigned char* tb_ = tl + u * 16384 + lane * 16;
                    unsigned sk[2];
#pragma unroll
                    for (int h2 = 0; h2 < 2; ++h2) {
                        float a01[2];
#pragma unroll
                        for (int e = 0; e < 2; ++e) {
                            f32x16 acc = {};
#pragma unroll
                            for (int st = 0; st < 4; ++st) acc = __builtin_amdgcn_mfma_f32_32x32x16_f16(*(const LAS f16x8*)(asl + st * 1024), *(const LAS f16x8*)(tb_ + (2 * h2 + e) * 4096 + st * 1024), acc, 0, 0, 0);
                            f32x2 s0 = {0.f, 0.f};
#pragma unroll
                            for (int q = 0; q < 16; q += 2) { f32x2 w2; w2.x = wv[q >> 2][q & 3]; w2.y = wv[(q + 1) >> 2][(q + 1) & 3]; f32x2 r0; r0.x = relu_bits(acc[q]); r0.y = relu_bits(acc[q + 1]); s0 = w2 * r0 + s0; }
                            float a = s0.x + s0.y; a += __shfl_xor(a, 32); a01[e] = a;
                        }
                        const float sv = hi ? a01[1] : a01[0]; const int key = 128 * t + 64 * h2 + lane;
                        sk[h2] = (key < limit) ? sortable(sv) : 0u;
                    }
                    switch (g6) {
#define IDX_PARK(k_) case k_: if (12 * k_ + 2 * u + 1 < 128) { v[(12 * k_ + 2 * u) & 127] = sk[0]; v[(12 * k_ + 2 * u + 1) & 127] = sk[1]; } break;
                        IDX_PARK(0) IDX_PARK(1) IDX_PARK(2) IDX_PARK(3) IDX_PARK(4) IDX_PARK(5) IDX_PARK(6) IDX_PARK(7) IDX_PARK(8) IDX_PARK(9) IDX_PARK(10)
#undef IDX_PARK
                        default: break;
                    }
                    asm volatile("s_waitcnt vmcnt(8)" ::: "memory"); asm volatile("s_waitcnt lgkmcnt(0)" ::: "memory"); __builtin_amdgcn_s_barrier(); asm volatile("" ::: "memory");
                }
                __builtin_amdgcn_sched_barrier(0);
            }
        }
#undef IDX_STAGE
        asm volatile("s_waitcnt vmcnt(0)" ::: "memory"); __builtin_amdgcn_s_barrier(); asm volatile("" ::: "memory");
        select_regs(F, (int)row, v);
    }
}

__device__ __forceinline__ void select_regs(Frame& F, int row, unsigned (&v)[128]) {
    const int lane = F.lane;
    unsigned long long* MK = (unsigned long long*)(F.ws + WS_MASK);
        const int t = row % SEQ, c = t / 64, nsl = c + 1;
        unsigned long long* mrow = MK + (size_t)row * 128;
        if (nsl <= 4) { int l_ = lane; asm volatile("" : "+v"(l_)); mrow[l_] = (l_ < nsl) ? ~0ull : 0ull; mrow[l_ + 64] = 0ull; return; }
        unsigned q0 = 0u, q1 = 0u, q2 = 0u, q3 = 0u;
#pragma unroll
        for (int g = 0; g < 8; ++g) if (g * 16 < nsl) {
#pragma unroll
            for (int j = 0; j < 16; j += 4) { q0 = q0 > v[g * 16 + j] ? q0 : v[g * 16 + j]; q1 = q1 > v[g * 16 + j + 1] ? q1 : v[g * 16 + j + 1];
                q2 = q2 > v[g * 16 + j + 2] ? q2 : v[g * 16 + j + 2]; q3 = q3 > v[g * 16 + j + 3] ? q3 : v[g * 16 + j + 3]; } }
        unsigned vmax = q0 > q1 ? q0 : q1; { const unsigned t2 = q2 > q3 ? q2 : q3; vmax = vmax > t2 ? vmax : t2; }
        unsigned lmin = q0 < q1 ? q0 : q1; { const unsigned t2 = q2 < q3 ? q2 : q3; lmin = lmin < t2 ? lmin : t2; }
#pragma unroll
        for (int o = 1; o < 64; o <<= 1) { const unsigned ot = __shfl_xor(vmax, o); vmax = vmax > ot ? vmax : ot; const unsigned ol = __shfl_xor(lmin, o); lmin = lmin < ol ? lmin : ol; }
        const unsigned dx = vmax ^ lmin;
        const int topbit = dx ? 31 - __builtin_clz(dx) : -1;
        unsigned prefix = (topbit >= 31) ? 0u : (topbit < 0 ? vmax : (vmax & ~((2u << topbit) - 1u))); bool exact = false;
        for (int bit = topbit; bit >= 0; --bit) {
            const unsigned cand = prefix | (1u << bit); unsigned cnt = 0u;
#pragma unroll
            for (int g = 0; g < 8; ++g) if (g * 16 < nsl) { unsigned cd = cand; asm volatile("" : "+v"(cd));
#pragma unroll
                for (int j = 0; j < 16; ++j) cnt += (v[g * 16 + j] >= cd) ? 1u : 0u; }
#pragma unroll
            for (int o = 1; o < 64; o <<= 1) cnt += __shfl_xor(cnt, o);
            if (cnt >= (unsigned)TOPK) prefix = cand;
            if (cnt == (unsigned)TOPK) { exact = true; break; }
        }
        if (exact) {
#pragma unroll
            for (int sl = 0; sl < 128; ++sl) { const unsigned long long word = (sl < nsl) ? __ballot(v[sl] >= prefix) : 0ull;
                mrow[sl] = word;
                if ((sl & 7) == 7) __builtin_amdgcn_sched_barrier(0); }
            return;
        }
        unsigned cgt = 0u;
#pragma unroll
        for (int g = 0; g < 8; ++g) if (g * 16 < nsl) {
#pragma unroll
            for (int j = 0; j < 16; ++j) cgt += (v[g * 16 + j] > prefix) ? 1u : 0u; }
#pragma unroll
        for (int o = 1; o < 64; o <<= 1) cgt += __shfl_xor(cgt, o);
        unsigned need = (unsigned)TOPK - cgt, seen = 0u;
#pragma unroll
        for (int g = 0; g < 8; ++g) {
#pragma unroll
            for (int j = 0; j < 16; ++j) { const int sl = g * 16 + j;
                unsigned long long word = 0ull;
                if (sl < nsl) {
                    const bool gt = v[sl] > prefix, eq = v[sl] == prefix;
                    const unsigned long long eqm = __ballot(eq);
                    const unsigned before = seen + (unsigned)__popcll(eqm & ((1ull << lane) - 1ull));
                    word = __ballot(gt || (eq && before < need));
                    seen += (unsigned)__popcll(eqm);
                }
                if (lane == 0) mrow[sl] = word; }
        }
}

__device__ __forceinline__ int t5_bucket(int rel) {
    const int n = rel < 0 ? -rel : rel; int bkt;
    if (n < 8) bkt = n; else bkt = 8 + (n >= 15) + (n >= 27) + (n >= 50) + (n >= 91) + (n >= 166) + (n >= 305) + (n >= 559);
    return (rel > 0 ? 16 : 0) + bkt;
}

namespace att {
constexpr int NW = 8, QBLK = 32, KVBLK = 64, QB = NW * QBLK, D = 128, LD = 2048;
constexpr int SHM_V = KVBLK * D * 2, SHM_K = KVBLK * D * 2;
constexpr int OFF_WS = 2 * SHM_V + 2 * SHM_K, OFF_TB = OFF_WS + NW * 64 * 4, TB_N = 1088, OFF_DK = OFF_TB, LDS_NEED = OFF_DK + 132 * 64 * 4;
constexpr float SCALE = 0.08838834764831845f, INV_SCALE = 11.313708498984761f, THR = 8.f;
typedef short bf16x8 __attribute__((ext_vector_type(8)));
typedef short s16x4 __attribute__((ext_vector_type(4)));
typedef float f32x16 __attribute__((ext_vector_type(16)));
typedef unsigned u32x4 __attribute__((ext_vector_type(4)));
#define KSWZ(row, colB) ((row) * 256 + ((colB) ^ (((row) & 7) << 4)))
#define K8SWZ(row, ch) ((row) * 128 + ((((ch) ^ (((row) >> 1) & 7))) << 4))
#define SBAR() __builtin_amdgcn_sched_barrier(0)
__device__ __forceinline__ int v_st(int k, int c) { const int kk = (k & ~0xC) | ((k & 4) << 1) | ((k & 8) >> 1); return ((kk >> 3) * 4 + (c >> 5)) * 512 + ((kk & 7) * 32 + (c & 31)) * 2; }
__device__ __forceinline__ int v_rd_base(int lane) { return ((lane & 3) << 3) | (((lane >> 2) & 3) << 6) | (((lane >> 4) & 1) << 5) | (((lane >> 5) & 1) << 8); }
constexpr int v_rd_off(int d0, int ks, int half) { return d0 * 512 + ks * 4096 + half * 2048; }
__device__ __forceinline__ int crow(int r, int hi) { return (r & 3) + 8 * (r >> 2) + 4 * hi; }
__device__ __forceinline__ unsigned cvtpk(float lo, float hi) { return pg8::cvt_pk_bf16(lo, hi); }
__device__ __forceinline__ void mask_tile(f32x16& p0, f32x16& p1, int lr, int sdq) {
    const float NEG = -__builtin_inff();
#pragma unroll
    for (int r = 0; r < 16; ++r) { const int c = (r & 3) + 8 * (r >> 2); if (lr < c - sdq) p0[r] = NEG; if (lr < c + 32 - sdq) p1[r] = NEG; }
}
template <bool F8P = false>
__device__ __forceinline__ void partialSM(f32x16& p0, f32x16& p1, float& m_reg, float& mn, float& alpha) {
    float pmax = p0[0];
#pragma unroll
    for (int r = 1; r < 16; ++r) pmax = fmaxf(pmax, p0[r]);
#pragma unroll
    for (int r = 0; r < 16; ++r) pmax = fmaxf(pmax, p1[r]);
    { auto rr = __builtin_amdgcn_permlane32_swap(__float_as_uint(pmax), __float_as_uint(pmax), false, false); pmax = fmaxf(__uint_as_float(rr[0]), __uint_as_float(rr[1])); }
    constexpr float C2 = 1.4426950408889634f * SCALE;
    if (__builtin_expect(__all((pmax - m_reg) * SCALE <= (F8P ? 4.5f : THR)), 1)) { mn = m_reg; alpha = 1.f; }
    else { mn = fmaxf(m_reg, pmax); alpha = __builtin_amdgcn_exp2f((m_reg - mn) * C2); m_reg = mn; }
    const float mnL = -mn * C2 + (F8P ? 2.f : 0.f);
#pragma unroll
    for (int r = 0; r < 16; ++r) p0[r] = fmaf(p0[r], C2, mnL);
#pragma unroll
    for (int r = 0; r < 16; ++r) p1[r] = fmaf(p1[r], C2, mnL);
#pragma unroll
    for (int r = 0; r < 16; ++r) p0[r] = __builtin_amdgcn_exp2f(p0[r]);
}
__device__ __forceinline__ void finishSM(f32x16& p0, f32x16& p1, float alpha, float& l_reg, bf16x8& pa0, bf16x8& pa1, bf16x8& pa2, bf16x8& pa3) {
#pragma unroll
    for (int r = 0; r < 16; ++r) p1[r] = __builtin_amdgcn_exp2f(p1[r]);
    float ps = 0;
#pragma unroll
    for (int r = 0; r < 16; ++r) ps += p0[r];
#pragma unroll
    for (int r = 0; r < 16; ++r) ps += p1[r];
    { auto rr = __builtin_amdgcn_permlane32_swap(__float_as_uint(ps), __float_as_uint(ps), false, false); ps = __uint_as_float(rr[0]) + __uint_as_float(rr[1]); }
    l_reg = l_reg * alpha + ps;
#define PK4(P, B_, OUT) do { unsigned a0 = cvtpk(P[B_+0], P[B_+1]), a1 = cvtpk(P[B_+2], P[B_+3]); unsigned b0 = cvtpk(P[B_+4], P[B_+5]), b1 = cvtpk(P[B_+6], P[B_+7]); \
        auto r0 = __builtin_amdgcn_permlane32_swap(a0, b0, false, false); auto r1 = __builtin_amdgcn_permlane32_swap(a1, b1, false, false); \
        u32x4 w = {r0[0], r1[0], r0[1], r1[1]}; OUT = *reinterpret_cast<bf16x8*>(&w); } while (0)
    PK4(p0, 0, pa0); PK4(p0, 8, pa1); PK4(p1, 0, pa2); PK4(p1, 8, pa3);
#undef PK4
}
template <int KB>
__device__ __forceinline__ void qkt8(f32x16& p0, f32x16& p1, const char* K_lds, int r32, int hi, const bf16x8* qr) {
    typedef int i32x4_ __attribute__((ext_vector_type(4))); typedef int i32x8_ __attribute__((ext_vector_type(8)));
    const char* kt = K_lds + KB * SHM_K;
#pragma unroll
    for (int j = 0; j < 2; ++j) {
        const i32x8_ qv = __builtin_shufflevector(__builtin_bit_cast(i32x4_, qr[2 * j]), __builtin_bit_cast(i32x4_, qr[2 * j + 1]), 0, 1, 2, 3, 4, 5, 6, 7);
        const int c0 = 4 * j + 2 * hi;
        const i32x8_ k0v = __builtin_shufflevector(*(const i32x4_*)(kt + K8SWZ(r32, c0)), *(const i32x4_*)(kt + K8SWZ(r32, c0 + 1)), 0, 1, 2, 3, 4, 5, 6, 7);
        const i32x8_ k1v = __builtin_shufflevector(*(const i32x4_*)(kt + K8SWZ(32 + r32, c0)), *(const i32x4_*)(kt + K8SWZ(32 + r32, c0 + 1)), 0, 1, 2, 3, 4, 5, 6, 7);
        p0 = __builtin_amdgcn_mfma_scale_f32_32x32x64_f8f6f4(k0v, qv, p0, 0, 0, 0, 0x7f7f7f7f, 0, 0x7f7f7f7f);
        p1 = __builtin_amdgcn_mfma_scale_f32_32x32x64_f8f6f4(k1v, qv, p1, 0, 0, 0, 0x7f7f7f7f, 0, 0x7f7f7f7f);
    }
}
template <int KB>
__device__ __forceinline__ void qkt(f32x16& p0, f32x16& p1, const char* K_lds, int r32, int hi, const bf16x8* qr) {
    const char* kb[4];
#pragma unroll
    for (int dd = 0; dd < 4; ++dd) kb[dd] = K_lds + KB * SHM_K + KSWZ(r32, (dd * 16 + hi * 8) * 2);
#pragma unroll
    for (int d0 = 0; d0 < 8; ++d0) { const char* a = kb[d0 & 3] + (d0 >> 2) * 128;
        bf16x8 b0 = *reinterpret_cast<const bf16x8*>(a);
        bf16x8 b1 = *reinterpret_cast<const bf16x8*>(a + 32 * 256);
        p0 = __builtin_amdgcn_mfma_f32_32x32x16_bf16(b0, qr[d0], p0, 0, 0, 0);
        p1 = __builtin_amdgcn_mfma_f32_32x32x16_bf16(b1, qr[d0], p1, 0, 0, 0); }
}
template <int VB>
__device__ __forceinline__ void pv_tile(f32x16* o, int vb0, bf16x8 pa0, bf16x8 pa1, bf16x8 pa2, bf16x8 pa3) {
#define TRRD(dst, off) asm volatile("ds_read_b64_tr_b16 %0, %1 offset:%2" : "=&v"(dst) : "v"(vb0), "i"(off) : "memory")
#define PV_D0(d0) do { s16x4 l0, l1, l2, l3, h0, h1, h2, h3; constexpr int b_ = VB * SHM_V + v_rd_off(d0, 0, 0); \
        TRRD(l0, b_); TRRD(h0, b_ + 2048); TRRD(l1, b_ + 4096); TRRD(h1, b_ + 6144); TRRD(l2, b_ + 8192); TRRD(h2, b_ + 10240); TRRD(l3, b_ + 12288); TRRD(h3, b_ + 14336); \
        asm volatile("s_waitcnt lgkmcnt(0)" ::: "memory"); SBAR(); \
        o[d0] = __builtin_amdgcn_mfma_f32_32x32x16_bf16(pa0, (bf16x8){l0[0], l0[1], l0[2], l0[3], h0[0], h0[1], h0[2], h0[3]}, o[d0], 0, 0, 0); \
        o[d0] = __builtin_amdgcn_mfma_f32_32x32x16_bf16(pa1, (bf16x8){l1[0], l1[1], l1[2], l1[3], h1[0], h1[1], h1[2], h1[3]}, o[d0], 0, 0, 0); \
        o[d0] = __builtin_amdgcn_mfma_f32_32x32x16_bf16(pa2, (bf16x8){l2[0], l2[1], l2[2], l2[3], h2[0], h2[1], h2[2], h2[3]}, o[d0], 0, 0, 0); \
        o[d0] = __builtin_amdgcn_mfma_f32_32x32x16_bf16(pa3, (bf16x8){l3[0], l3[1], l3[2], l3[3], h3[0], h3[1], h3[2], h3[3]}, o[d0], 0, 0, 0); } while (0)
    PV_D0(0); PV_D0(1); PV_D0(2); PV_D0(3);
#undef PV_D0
#undef TRRD
}
#define V8SWZ(row, ch) ((row) * 128 + ((((ch) ^ ((row) & 7))) << 4))
__device__ __forceinline__ void finishSM8(f32x16& p0, f32x16& p1, float alpha, float& l_reg, bf16x8& pa0, bf16x8& pa1) {
#pragma unroll
    for (int r = 0; r < 16; ++r) p1[r] = __builtin_amdgcn_exp2f(p1[r]);
    float ps = 0;
#pragma unroll
    for (int r = 0; r < 16; ++r) ps += p0[r];
#pragma unroll
    for (int r = 0; r < 16; ++r) ps += p1[r];
    { auto rr = __builtin_amdgcn_permlane32_swap(__float_as_uint(ps), __float_as_uint(ps), false, false); ps = __uint_as_float(rr[0]) + __uint_as_float(rr[1]); }
    l_reg = l_reg * alpha + ps;
    unsigned w[8];
#pragma unroll
    for (int g = 0; g < 4; ++g) {
        int x = __builtin_amdgcn_cvt_pk_fp8_f32(p0[4 * g], p0[4 * g + 1], 0, false); x = __builtin_amdgcn_cvt_pk_fp8_f32(p0[4 * g + 2], p0[4 * g + 3], x, true);
        int y = __builtin_amdgcn_cvt_pk_fp8_f32(p1[4 * g], p1[4 * g + 1], 0, false); y = __builtin_amdgcn_cvt_pk_fp8_f32(p1[4 * g + 2], p1[4 * g + 3], y, true);
        auto rr = __builtin_amdgcn_permlane32_swap((unsigned)x, (unsigned)y, false, false);
        w[2 * g] = rr[0]; w[2 * g + 1] = rr[1]; }
    u32x4 a = {w[0], w[1], w[2], w[3]}, b = {w[4], w[5], w[6], w[7]};
    pa0 = *reinterpret_cast<bf16x8*>(&a); pa1 = *reinterpret_cast<bf16x8*>(&b);
}
template <int VB>
__device__ __forceinline__ void pv_tile8(f32x16* o, int vbase, int vb8, bf16x8 pa0, bf16x8 pa1) {
    typedef int i32x4_ __attribute__((ext_vector_type(4))); typedef int i32x8_ __attribute__((ext_vector_type(8))); typedef int i32x2_ __attribute__((ext_vector_type(2)));
    const i32x8_ pv = __builtin_shufflevector(__builtin_bit_cast(i32x4_, pa0), __builtin_bit_cast(i32x4_, pa1), 0, 1, 2, 3, 4, 5, 6, 7);
#pragma unroll
    for (int db = 0; db < 4; ++db) {
        const int ad = vbase + (vb8 ^ (db << 5));
        i32x2_ t0, t1, t2, t3;
        asm volatile("ds_read_b64_tr_b8 %0, %1 offset:%2" : "=&v"(t0) : "v"(ad), "i"(VB * SHM_V) : "memory");
        asm volatile("ds_read_b64_tr_b8 %0, %1 offset:%2" : "=&v"(t1) : "v"(ad), "i"(VB * SHM_V + 1024) : "memory");
        asm volatile("ds_read_b64_tr_b8 %0, %1 offset:%2" : "=&v"(t2) : "v"(ad), "i"(VB * SHM_V + 2048) : "memory");
        asm volatile("ds_read_b64_tr_b8 %0, %1 offset:%2" : "=&v"(t3) : "v"(ad), "i"(VB * SHM_V + 3072) : "memory");
        asm volatile("s_waitcnt lgkmcnt(0)" ::: "memory"); SBAR();
        const i32x8_ vv = {t0[0], t0[1], t1[0], t1[1], t2[0], t2[1], t3[0], t3[1]};
        o[db] = __builtin_amdgcn_mfma_scale_f32_32x32x64_f8f6f4(pv, vv, o[db], 0, 0, 0, 0x7f7f7f7f, 0, 0x7f7f7f7f);
    }
}
struct BlockRef { const bf16* Q; const bf16* K; const bf16* V; bf16* O; int P0, jlo; const unsigned long long* MK; const float* cum; };
struct Seam { bf16x8 qr[8]; bf16x8 st_v0, st_v1, st_k0, st_k1; };
#define AROW(p, k0, rr) ((p) + (size_t)((k0) + (rr)) * LD + sc)
#define VMW() asm volatile("s_waitcnt vmcnt(0)" ::: "memory")
#define VMWN(n) asm volatile("s_waitcnt vmcnt(%0)" :: "i"(n) : "memory")
#define SLOAD_H(Kp, Vp, k0) do { \
        if constexpr (MODE == 0) { S.st_v0 = *(const bf16x8*)((const char*)(Vp) + (size_t)((k0) + (tid >> 3)) * LD + (tid & 7) * 16); S.st_k0 = *(const bf16x8*)((const char*)(Kp) + (size_t)((k0) + (tid >> 3)) * LD + (tid & 7) * 16); } \
        else { S.st_v0 = *(const bf16x8*)AROW(Vp, k0, sr); S.st_v1 = *(const bf16x8*)AROW(Vp, k0, 32 + sr); S.st_k0 = *(const bf16x8*)AROW(Kp, k0, sr); S.st_k1 = *(const bf16x8*)AROW(Kp, k0, 32 + sr); } } while (0)
#define SWRITE_HK(bf) do { if constexpr (MODE == 0) { *(bf16x8*)(K_lds + (bf) * SHM_K + K8SWZ(tid >> 3, tid & 7)) = S.st_k0; } \
        else { *(bf16x8*)(K_lds + (bf) * SHM_K + kws) = S.st_k0; *(bf16x8*)(K_lds + (bf) * SHM_K + kws + 32 * 256) = S.st_k1; } } while (0)
#define QLOAD(Qp) do { if constexpr (MODE == 0) { const char* q8_ = (const char*)(Qp) + (size_t)(wid * QBLK + r32) * LD + 32 * hi; \
            S.qr[0] = *(const bf16x8*)(q8_); S.qr[1] = *(const bf16x8*)(q8_ + 16); S.qr[2] = *(const bf16x8*)(q8_ + 64); S.qr[3] = *(const bf16x8*)(q8_ + 80); } \
        else { _Pragma("unroll") for (int d0 = 0; d0 < 8; ++d0) S.qr[d0] = *(const bf16x8*)((Qp) + (size_t)(wid * QBLK + r32) * LD + d0 * 16 + hi * 8); } } while (0)
#define SWRITE_HV(bf) do { if constexpr (MODE == 0) { *(bf16x8*)(V_lds + (bf) * SHM_V + V8SWZ(tid >> 3, tid & 7)) = S.st_v0; } \
        else { *(bf16x8*)(V_lds + (bf) * SHM_V + vst0) = S.st_v0; *(bf16x8*)(V_lds + (bf) * SHM_V + vst1) = S.st_v1; } } while (0)
template <int MODE>
__device__ __forceinline__ void attn_prime(const BlockRef& cur, char* lds, Seam& S) {
    int tid_ = threadIdx.x; asm volatile("" : "+v"(tid_)); const int tid = tid_, wid = __builtin_amdgcn_readfirstlane(tid >> 6), lane = tid & 63, r32 = lane & 31, hi = lane >> 5;
    const int sr = tid >> 4, sc = (tid & 15) * 8, kws = KSWZ(sr, sc * 2); char* K_lds = lds + 2 * SHM_V;
    const int kb0 = cur.jlo * KVBLK;
    QLOAD(cur.Q);
    SLOAD_H(cur.K, cur.V, kb0); VMW(); SWRITE_HK(0);
    __syncthreads();
}
template <int MODE>
__device__ __forceinline__ void attn_block(const BlockRef& cur, const BlockRef& nxt, const float* bias_h, char* lds, Seam& S) {
    int tid_ = threadIdx.x; asm volatile("" : "+v"(tid_)); const int tid = tid_, wid = __builtin_amdgcn_readfirstlane(tid >> 6), lane = tid & 63, r32 = lane & 31, hi = lane >> 5;
    const int j_lo = cur.jlo, j_hi = cur.P0 / KVBLK + 4, NT = j_hi - j_lo;
    const int kbn = nxt.jlo * KVBLK;
    const int qlo = cur.P0 + wid * QBLK; int lr = r32 - 4 * hi; asm volatile("" : "+v"(lr));
    char* V_lds = lds; char* K_lds = lds + 2 * SHM_V;
    float* ws = (float*)(lds + OFF_WS) + wid * 64; float* li_l = ws, * al_l = ws + 32;
    float* tb = (float*)(lds + OFF_TB); float* dkb = (float*)(lds + OFF_DK);
    float m_reg = -1e30f, l_reg = 0; f32x16 o[4] = {};
    const int sr = tid >> 4, sc = (tid & 15) * 8, vst0 = v_st(sr, sc), vst1 = v_st(32 + sr, sc), kws = KSWZ(sr, sc * 2);
    const int vb0 = (int)(uintptr_t)V_lds + v_rd_base(lane);
    const int vb8 = (32 * hi + ((lane & 15) >> 1)) * 128 + (((((lane >> 4) & 1)) ^ ((lane & 15) >> 1)) << 4) + 8 * (lane & 1);
#define FIN(P0_, P1_, al_) do { if constexpr (MODE == 0) finishSM8(P0_, P1_, al_, l_reg, pa0, pa1); else finishSM(P0_, P1_, al_, l_reg, pa0, pa1, pa2, pa3); } while (0)
#define PVT(VB_) do { if constexpr (MODE == 0) pv_tile8<VB_>(o, (int)(uintptr_t)V_lds, vb8, pa0, pa1); else pv_tile<VB_>(o, vb0, pa0, pa1, pa2, pa3); } while (0)
#define PSM(P0_, P1_, mn_, al_) partialSM<MODE == 0>(P0_, P1_, m_reg, mn_, al_)
    const bf16* Kh = cur.K; const bf16* Vh = cur.V;
    const float NEG = -__builtin_inff();
    const unsigned long long* mrow = nullptr; unsigned long long mw_cur = 0ull, mw_nxt = 0ull; float c15 = 0.f;
    float cref = 0.f;
    if constexpr (MODE == 0) {
        mrow = cur.MK + (size_t)(wid * QBLK + r32) * 128;
        for (int i = tid; i < TB_N; i += NW * 64) tb[i] = bias_h[t5_bucket(i - 1023) * NH] * INV_SCALE;
        c15 = bias_h[15 * NH] * INV_SCALE;
        mw_cur = mrow[j_lo];
    } else {
        cref = cur.cum[cur.P0];
        for (int i = tid; i < NT * KVBLK; i += NW * 64) dkb[i] = -(cur.cum[j_lo * KVBLK + i] - cref) * INV_SCALE;
    }
#define RESC(a) do { if (__any((a) < 1.f)) { if (hi == 0) al_l[r32] = (a); asm volatile("s_waitcnt lgkmcnt(0)" ::: "memory"); \
                     for (int d_ = 0; d_ < 4; ++d_) for (int r = 0; r < 16; ++r) o[d_][r] *= al_l[crow(r, hi)]; } } while (0)
#define KBASE(t) ((j_lo + (t)) * KVBLK)
#define PINIT(P0_, P1_, t, DB) do { \
        if constexpr (MODE == 0) { const unsigned lo_ = (unsigned)mw_cur >> (4 * hi), hi_ = (unsigned)(mw_cur >> 32) >> (4 * hi); const int kb_ = KBASE(t); \
            if (kb_ + 63 - qlo <= -559) { _Pragma("unroll") for (int r = 0; r < 16; ++r) { const int c = (r & 3) + 8 * (r >> 2); P0_[r] = ((lo_ >> c) & 1u) ? c15 : NEG; P1_[r] = ((hi_ >> c) & 1u) ? c15 : NEG; } } \
            else { const float* tq_ = tb + (kb_ - (qlo + r32) + 4 * hi + 1023); \
                _Pragma("unroll") for (int r = 0; r < 16; ++r) { const int c = (r & 3) + 8 * (r >> 2); const float b0_ = tq_[c], b1_ = tq_[c + 32]; P0_[r] = ((lo_ >> c) & 1u) ? b0_ : NEG; P1_[r] = ((hi_ >> c) & 1u) ? b1_ : NEG; } } \
            if ((t) + 1 < NT) mw_nxt = mrow[j_lo + (t) + 1]; \
        } else { const float* dq_ = dkb + (t) * 64 + 4 * hi; \
            _Pragma("unroll") for (int g = 0; g < 4; ++g) { const f32x4 a_ = *(const f32x4*)(dq_ + 8 * g), b_ = *(const f32x4*)(dq_ + 32 + 8 * g); \
                P0_[4 * g] = a_[0]; P0_[4 * g + 1] = a_[1]; P0_[4 * g + 2] = a_[2]; P0_[4 * g + 3] = a_[3]; P1_[4 * g] = b_[0]; P1_[4 * g + 1] = b_[1]; P1_[4 * g + 2] = b_[2]; P1_[4 * g + 3] = b_[3]; } } \
    } while (0)
#define PNEXT() do { if constexpr (MODE == 0) mw_cur = mw_nxt; } while (0)
#define MASKT(P0_, P1_, t) do { if constexpr (MODE == 1) { const int kb_ = KBASE(t); if (kb_ + KVBLK - 1 > qlo) mask_tile(P0_, P1_, lr, qlo - kb_); } } while (0)
#define DKLOAD(t) do { } while (0)
#define DKWRITE(bf) do { } while (0)
#define QKT(KB_, P0_, P1_) do { if constexpr (MODE == 0) qkt8<KB_>(P0_, P1_, K_lds, r32, hi, S.qr); else qkt<KB_>(P0_, P1_, K_lds, r32, hi, S.qr); } while (0)
    constexpr int NQL = (MODE == 0) ? 4 : 8;
#define SEAM_K0() do { VMWN(NQL); SWRITE_HK(0); SBAR(); } while (0)
    f32x16 pA0, pA1, pB0, pB1; float mnA, mnB, alA, alB; bf16x8 pa0, pa1, pa2, pa3;
    SWRITE_HV(0); SBAR();
    __syncthreads();
    if (NT > 1) { SLOAD_H(Kh, Vh, KBASE(1)); DKLOAD(1); }
    SBAR(); PINIT(pA0, pA1, 0, 0); QKT(0, pA0, pA1); PNEXT();
    MASKT(pA0, pA1, 0); PSM(pA0, pA1, mnA, alA);
    if (NT > 1) { VMW(); SWRITE_HV(1); SWRITE_HK(1); DKWRITE(1); }
    __syncthreads();
#define HALF_STEP(PX0, PX1, mnX, alX, PY0, PY1, alY, t, KB, VB, SB) do { \
        SBAR(); PINIT(PX0, PX1, t, KB); QKT(KB, PX0, PX1); \
        FIN(PY0, PY1, alY); SBAR(); \
        if ((t) + 1 < NT) { SLOAD_H(Kh, Vh, KBASE((t) + 1)); DKLOAD((t) + 1); SBAR(); } \
        PVT(VB); MASKT(PX0, PX1, (t)); PSM(PX0, PX1, mnX, alX); \
        __syncthreads(); \
        if ((t) + 1 < NT) { VMW(); SWRITE_HV(SB); SWRITE_HK(SB); DKWRITE(SB); } \
        PNEXT(); RESC(alX); __syncthreads(); } while (0)
    for (int t = 1; t + 1 < NT; t += 2) {
        HALF_STEP(pB0, pB1, mnB, alB, pA0, pA1, alA, t, 1, 0, 0);
        HALF_STEP(pA0, pA1, mnA, alA, pB0, pB1, alB, t + 1, 0, 1, 1);
    }
    const bool even = (NT & 1) == 0;
    if (even) { SBAR(); PINIT(pB0, pB1, NT - 1, 1); QKT(1, pB0, pB1); PNEXT(); SBAR(); }
    VMW();
    SLOAD_H(nxt.K, nxt.V, kbn); SBAR();
    { int qo_ = (wid * QBLK + r32) * LD; asm volatile("" : "+v"(qo_));
      if constexpr (MODE == 0) { const char* q8_ = (const char*)nxt.Q + qo_ + 32 * hi; S.qr[0] = *(const bf16x8*)(q8_); S.qr[1] = *(const bf16x8*)(q8_ + 16); S.qr[2] = *(const bf16x8*)(q8_ + 64); S.qr[3] = *(const bf16x8*)(q8_ + 80); }
      else {
#pragma unroll
        for (int d0 = 0; d0 < 8; ++d0) S.qr[d0] = *(const bf16x8*)(nxt.Q + qo_ + hi * 8 + d0 * 16); } }
    SBAR();
    FIN(pA0, pA1, alA); SBAR();
    PVT(0);
    if (even) { MASKT(pB0, pB1, NT - 1); PSM(pB0, pB1, mnB, alB); __syncthreads(); RESC(alB);
        FIN(pB0, pB1, alB); SBAR(); PVT(1); }
    SBAR(); SEAM_K0();
    if (hi == 0) li_l[r32] = l_reg; asm volatile("s_waitcnt lgkmcnt(0)" ::: "memory");
    float rli[16];
#pragma unroll
    for (int r = 0; r < 16; ++r) rli[r] = __builtin_amdgcn_rcpf(li_l[crow(r, hi)]);
    int oo_ = (wid * QBLK + 4 * hi) * LD + r32; asm volatile("" : "+v"(oo_));
    unsigned char* Ow = (unsigned char*)cur.O + oo_;
#pragma unroll
    for (int r = 0; r < 16; ++r) { const int orow = (r & 3) + 8 * (r >> 2);
#pragma unroll
        for (int d0 = 0; d0 < 4; ++d0) { const float v = o[d0][r] * (rli[r] * 16.f); const float vn = __shfl_xor(v, 1);
            if ((r32 & 1) == 0) *(unsigned short*)(Ow + orow * LD + d0 * 32) = (unsigned short)__builtin_amdgcn_cvt_pk_fp8_f32(v, vn, 0, false); } }
    __syncthreads();
#undef RESC
#undef KBASE
#undef PINIT
#undef PNEXT
#undef MASKT
#undef DKLOAD
#undef DKWRITE
#undef SEAM_K0
#undef HALF_STEP
#undef QKT
#undef FIN
#undef PVT
#undef PSM
}
#undef AROW
#undef VMW
#undef VMWN
#undef SLOAD_H
#undef SWRITE_HK
#undef SWRITE_HV
#undef KSWZ
#undef K8SWZ
#undef V8SWZ
#undef QLOAD
#undef SBAR
}

constexpr float FOX_SKIP = -40.0f;
__device__ __forceinline__ int fox_jlo(Frame& F, int bh, int qb) {
    const float* kn = (const float*)(F.ws + WS_NORM) + (size_t)bh * 128; const float* qn = (const float*)(F.ws + WS_NORM) + (size_t)(BATCH * NH + bh) * 128;
    const float* cum = (const float*)(F.ws + WS_CUM) + (size_t)bh * SEQ;
    const int j0 = 4 * qb, lane = F.lane;
    const float Qm = fmaxf(fmaxf(qn[j0], qn[j0 + 1]), fmaxf(qn[j0 + 2], qn[j0 + 3])), Kd = fmaxf(fmaxf(kn[j0], kn[j0 + 1]), fmaxf(kn[j0 + 2], kn[j0 + 3]));
    const float c0 = cum[256 * qb];
    bool keep0 = true, keep1 = true;
    if (lane < j0) keep0 = !(Qm * (kn[lane] + Kd) * ATT_SCALE + (c0 - cum[64 * lane + 63]) < FOX_SKIP);
    if (64 + lane < j0) keep1 = !(Qm * (kn[64 + lane] + Kd) * ATT_SCALE + (c0 - cum[64 * (64 + lane) + 63]) < FOX_SKIP);
    const unsigned long long m0 = __ballot(keep0), m1 = __ballot(keep1);
    const int jl = m0 ? __builtin_ctzll(m0) : 64 + __builtin_ctzll(m1);
    return __builtin_amdgcn_readfirstlane(jl);
}
template <int MODE>
__device__ __forceinline__ att::BlockRef p4_ref(Frame& F, int L, int jlo) {
    const int xcd = L & 7, k = (L >> 3) & 31, i = L >> 8, bh = 4 * xcd + ((MODE == 1) ? (((k >> 3) + i) & 3) : (k >> 3)), p = k & 7, b = bh >> 4, h = bh & 15;
    const int qb = (i == 0) ? p : (i == 1) ? 31 - p : (i == 2) ? 8 + p : 23 - p;
    bf16* E = (bf16*)(F.ws + WS_E); const size_t TS = (size_t)M * DA;
    att::BlockRef r; const size_t rowq = (size_t)b * SEQ + (size_t)qb * 256, rowk = (size_t)b * SEQ;
    if constexpr (MODE == 0) { r.Q = (const bf16*)(F.ws + WS_E + rowq * DA + h * HD); r.O = (bf16*)(F.ws + WS_Y8A + rowq * DA + h * HD); r.K = (const bf16*)(F.ws + WS_E + 2 * ACT2K + rowk * DA + h * HD); r.V = (const bf16*)(F.ws + WS_E + 3 * ACT2K + rowk * DA + h * HD); }
    else { r.Q = E + TS + rowq * DA + h * HD; r.O = (bf16*)(F.ws + WS_Y8B + rowq * DA + h * HD); r.K = E + 4 * TS + rowk * DA + h * HD; r.V = E + 5 * TS + rowk * DA + h * HD; }
    r.P0 = qb * 256; r.jlo = jlo;
    r.MK = (const unsigned long long*)(F.ws + WS_MASK) + rowq * 128; r.cum = (const float*)(F.ws + WS_CUM) + (size_t)(b * NH + h) * SEQ;
    return r;
}
__device__ __forceinline__ void p4_decode(int L, int mode, int& bh, int& qb) {
    const int xcd = L & 7, k = (L >> 3) & 31, i = L >> 8, p = k & 7;
    bh = 4 * xcd + (mode ? (((k >> 3) + i) & 3) : (k >> 3)); qb = (i == 0) ? p : (i == 1) ? 31 - p : (i == 2) ? 8 + p : 23 - p;
}
template <int MODE>
__device__ __forceinline__ void p4_attention_branch(Frame& F, char* lds) {
    const int G = F.G; int L = blockIdx.x; if (L >= 1024) return;
    int jl[4] = {0, 0, 0, 0};
    if constexpr (MODE == 1) {
#pragma unroll
        for (int i = 0; i < 4; ++i) { const int Li = L + i * G; if (Li < 1024) { int bh, qb; p4_decode(Li, 1, bh, qb); jl[i] = fox_jlo(F, bh, qb); } }
    }
    int bi = 0;
    att::BlockRef cur = p4_ref<MODE>(F, L, jl[0]); att::Seam S;
    att::attn_prime<MODE>(cur, lds, S);
    for (;;) {
        const bool last = L + G >= 1024 || bi >= 3; const int Ln = last ? L : L + G;
        const int jn = (bi == 0) ? jl[1] : (bi == 1) ? jl[2] : jl[3];
        const att::BlockRef nxt = last ? cur : p4_ref<MODE>(F, Ln, jn);
        int bh, qb; p4_decode(L, MODE, bh, qb);
        att::attn_block<MODE>(cur, nxt, F.rel_bias + (bh & 15), lds, S);
        if (last) break;
        cur = nxt; L = Ln; ++bi;
    }
}

template <bool TO_BF16>
__device__ __forceinline__ void rmsnorm_rows(Frame& F, const float* src, const float* g, float* dstf, bf16* dstb) {
    const int gw = F.vcu * NWAVES + F.wave, NGW = F.G * NWAVES;
    for (int m = gw; m < M; m += NGW) {
        const GAS f32x4* xr = (const GAS f32x4*)(src + (size_t)m * DM) + F.lane; const GAS f32x4* gr = (const GAS f32x4*)g + F.lane;
        f32x4 v[16]; float s = 0.f;
#pragma unroll
        for (int j = 0; j < 16; ++j) { v[j] = xr[64 * j]; s += (v[j].x * v[j].x + v[j].y * v[j].y) + (v[j].z * v[j].z + v[j].w * v[j].w); }
        const float rstd = 1.0f / sqrtf(wave_sum(s) * (1.f / DM) + EPS);
        if constexpr (TO_BF16) { GAS unsigned long long* o8 = (GAS unsigned long long*)(dstb + (size_t)m * DM) + F.lane;
#pragma unroll
            for (int j = 0; j < 16; ++j) { const f32x4 gg = gr[64 * j];
                o8[64 * j] = (unsigned long long)pk2bf(v[j].x * rstd * gg.x, v[j].y * rstd * gg.y) | ((unsigned long long)pk2bf(v[j].z * rstd * gg.z, v[j].w * rstd * gg.w) << 32); } }
        else { GAS f32x4* o = (GAS f32x4*)(dstf + (size_t)m * DM) + F.lane;
#pragma unroll
            for (int j = 0; j < 16; ++j) { const f32x4 gg = gr[64 * j]; o[64 * j] = v[j] * rstd * gg; } }
    }
}

__device__ __forceinline__ void final_norm_rows(Frame& F, const bf16* src, const float* g, float* dst) {
    const int gw = F.vcu * NWAVES + F.wave, NGW = F.G * NWAVES;
    for (int m = gw; m < M; m += NGW) {
        const GAS v4u* xr = (const GAS v4u*)(src + (size_t)m * DM) + F.lane; const GAS f32x4* gr = (const GAS f32x4*)g + 2 * F.lane;
        v4u v[8]; float s = 0.f;
#pragma unroll
        for (int j = 0; j < 8; ++j) v[j] = xr[64 * j];
#pragma unroll
        for (int j = 0; j < 8; ++j) { const float a0 = pg8::bf_lo(v[j].x), a1 = pg8::bf_hi(v[j].x), a2 = pg8::bf_lo(v[j].y), a3 = pg8::bf_hi(v[j].y), a4 = pg8::bf_lo(v[j].z), a5 = pg8::bf_hi(v[j].z), a6 = pg8::bf_lo(v[j].w), a7 = pg8::bf_hi(v[j].w);
            s += ((a0 * a0 + a1 * a1) + (a2 * a2 + a3 * a3)) + ((a4 * a4 + a5 * a5) + (a6 * a6 + a7 * a7)); }
        const float rstd = 1.0f / sqrtf(wave_sum(s) * (1.f / DM) + EPS);
        GAS f32x4* o = (GAS f32x4*)(dst + (size_t)m * DM) + 2 * F.lane;
#pragma unroll
        for (int j = 0; j < 8; ++j) { const f32x4 g0 = gr[128 * j], g1 = gr[128 * j + 1];
            f32x4 y0 = {pg8::bf_lo(v[j].x), pg8::bf_hi(v[j].x), pg8::bf_lo(v[j].y), pg8::bf_hi(v[j].y)}, y1 = {pg8::bf_lo(v[j].z), pg8::bf_hi(v[j].z), pg8::bf_lo(v[j].w), pg8::bf_hi(v[j].w)};
            o[128 * j] = y0 * rstd * g0; o[128 * j + 1] = y1 * rstd * g1; }
    }
}

constexpr int N_PHASES = 12;
struct Args { const float* in[12]; float* out; unsigned char* ws; int ph_lo, ph_hi, li, pad; };
__global__ void __launch_bounds__(NWAVES * 64, 2) fwd(Args args) {
    extern __shared__ __attribute__((aligned(16))) unsigned char lds[];
    Frame F;
    F.lds = (LAS unsigned char*)lds;
    F.MISC = (volatile LAS unsigned*)(F.lds + MISC_OFF);
    F.tid = threadIdx.x; F.lane = F.tid & 63; F.wave = __builtin_amdgcn_readfirstlane(F.tid >> 6);
    F.G = gridDim.x; { const int bx = blockIdx.x; F.vcu = (F.G % 8 == 0) ? (bx % 8) * (F.G / 8) + bx / 8 : bx; }
    F.ws = args.ws; F.ctl = (gu32*)(args.ws + WS_CTL);
    F.x = args.in[0]; F.w_in = args.in[1]; F.b_f = args.in[2]; F.w_out_a = args.in[3]; F.w_out_b = args.in[4]; F.w_o = args.in[5]; F.w_up = args.in[6]; F.w_down = args.in[7];
    F.g_mix = args.in[8]; F.g_mlp = args.in[9]; F.g_final = args.in[10]; F.rel_bias = args.in[11]; F.out = args.out;
    for (int u = F.tid; u < (LDS_BYTES - LDSCTL_OFF) / 4; u += NWAVES * 64) ((LAS unsigned*)(F.lds + LDSCTL_OFF))[u] = 0u;
    __syncthreads();
    XcdBarrier bar = xcd_barrier_post((unsigned*)(F.ctl + CW_BAR) + args.li * XCD_BAR_WORDS, F.MISC + 8);
    const int lo = args.ph_lo, hi = args.ph_hi;
#define IN(k) (lo <= (k) && (k) < hi)
#define SEAM(k) do { if (IN(k) && IN((k) + 1)) xcd_barrier(bar); } while (0)
#define LANES() do { int t_ = threadIdx.x; asm volatile("" : "+v"(t_)); F.tid = t_; F.lane = t_ & 63; } while (0)
    unsigned char* ws = args.ws;
    if (IN(0)) { LANES(); p0_prologue(F); } SEAM(0);
    if (IN(1)) { LANES();
        { pg8::Gemm g{(const bf16*)(ws + WS_XN8), (const bf16*)(ws + WS_WIN8), M, DST_IQ, DM / 2}; pg8::StaticOrder S; S.init(M, DST_IQ, F.G, (int)blockIdx.x);
          EpiInProj<0> E{ws, F.b_f, 0, 1.0f / 64.0f};
          pg8::gemm_phase<EpiInProj<0>, pg8::StaticOrder, 2>(F.lds + RING_OFF, g, S, E); }
        pg8::Gemm g{(const bf16*)(ws + WS_XN), (const bf16*)(ws + WS_WINH), M, NPAD - DST_IQ, DM}; pg8::StaticOrder S; S.init(M, NPAD - DST_IQ, F.G, (int)blockIdx.x);
        EpiInProj<1> E{ws, F.b_f, TILE_IQ0, 1.0f};
        pg8::gemm_phase<EpiInProj<1>, pg8::StaticOrder, 1>(F.lds + RING_OFF, g, S, E);
        { const int nunits = (M / 256) * (NPAD / 256), nlast = nunits % F.G, nidle = F.G - nlast;
          if (nlast == 0) p1_convert_small_weights(F, (int)blockIdx.x, F.G);
          else if ((int)blockIdx.x >= nlast) p1_convert_small_weights(F, (int)blockIdx.x - nlast, nidle); }
    } SEAM(1);
    if (IN(2)) { LANES(); p2_scores(F); __syncthreads(); p2_index_select(F); } SEAM(2);
    if (IN(4)) { LANES(); p4_attention_branch<0>(F, (char*)lds + RING_OFF); __syncthreads(); p4_attention_branch<1>(F, (char*)lds + RING_OFF); } SEAM(4);
    if (IN(5)) { LANES();
        { const int nunits = (M / 256) * (NPAD / 256), nlast = nunits % F.G, nidle = (nlast == 0) ? F.G : F.G - nlast; constexpr int I_UP = (DM / 64) * (DFF / 64);
          const int nearly = UP_EARLY_PER_WAVE * nidle * NWAVES; p5_convert_mlp_weights(F, nearly < I_UP ? nearly : I_UP); } __syncthreads();
        pg8::Gemm g{(const bf16*)(ws + WS_Y8A), (const bf16*)(ws + WS_WOA), M, DM, DA / 2}; pg8::StaticOrder S; S.init(M, DM, F.G, (int)blockIdx.x);
        EpiGate<false> E{ws + WS_GA, nullptr, (bf16*)(ws + WS_T), 1.0f / 1024.0f};
        pg8::gemm_phase<EpiGate<false>, pg8::StaticOrder, 2>(F.lds + RING_OFF, g, S, E);
    }
    if (IN(6)) { LANES();
        pg8::Gemm g{(const bf16*)(ws + WS_Y8B), (const bf16*)(ws + WS_WOB), M, DM, DA / 2}; pg8::StaticOrder S; S.init(M, DM, F.G, (int)blockIdx.x);
        EpiGate<true> E{ws + WS_GB, (bf16*)(ws + WS_T), (bf16*)(ws + WS_MERGED), 1.0f / 1024.0f};
        pg8::gemm_phase<EpiGate<true>, pg8::StaticOrder, 2>(F.lds + RING_OFF, g, S, E);
    } SEAM(6);
    if (IN(7)) { LANES();
        pg8::Gemm g{(const bf16*)(ws + WS_MERGED), (const bf16*)(ws + WS_WO), M, DM, DM / 2}; pg8::StaticOrder S; S.init(M, DM, F.G, (int)blockIdx.x);
        EpiResidNorm E{F.x, (bf16*)(ws + WS_X1B), (float*)(ws + WS_SSP), 1.0f / 1024.0f};
        pg8::gemm_phase<EpiResidNorm, pg8::StaticOrder, 2>(F.lds + RING_OFF, g, S, E);
    } SEAM(7);
    if (IN(9)) { LANES();
        pg8::Gemm g{(const bf16*)(ws + WS_X1B), (const bf16*)(ws + WS_WUP), M, DFF, DM}; pg8::StaticOrder S; S.init(M, DFF, F.G, (int)blockIdx.x);
        EpiUp E{(bf16*)(ws + WS_H), (const float*)(ws + WS_SSP), (LAS float*)(F.lds + RSTD_LDS_OFF), -1};
        pg8::gemm_phase<EpiUp, pg8::StaticOrder, 0>(F.lds + RING_OFF, g, S, E);
    } SEAM(9);
    if (IN(10)) { LANES();
        pg8::Gemm g{(const bf16*)(ws + WS_H), (const bf16*)(ws + WS_WDN), M, DM, DFF}; pg8::StaticOrder S; S.init(M, DM, F.G, (int)blockIdx.x, 4);
        EpiResid E{(const bf16*)(ws + WS_X1B), (bf16*)(ws + WS_X2B)};
        pg8::gemm_phase<EpiResid, pg8::StaticOrder, 0>(F.lds + RING_OFF, g, S, E);
    } SEAM(10);
    if (IN(11)) { LANES(); final_norm_rows(F, (const bf16*)(ws + WS_X2B), F.g_final, F.out); }
#undef IN
#undef SEAM
}

#ifndef MK_N_LAUNCHES
#define MK_N_LAUNCHES 1
#endif
extern "C" void kernel_launch(void* const* d_in, const int* in_sizes, int n_in, void* d_out, int out_size, void* d_ws, size_t ws_size, hipStream_t stream) {
    static int grid = 0;
    if (grid == 0) {
        if (n_in != 12 || out_size != M * DM || ws_size < WS_END) { fprintf(stderr, "kernel_launch: unexpected shapes / workspace (n_in %d out %d ws %zu, need %zu)\n", n_in, out_size, ws_size, (size_t)WS_END); grid = -1; return; }
        int dev = 0, cus = 0, per_cu = 0;
        if (hipGetDevice(&dev) != hipSuccess || hipDeviceGetAttribute(&cus, hipDeviceAttributeMultiprocessorCount, dev) != hipSuccess) { grid = -1; return; }
        if (hipFuncSetAttribute((const void*)fwd, hipFuncAttributeMaxDynamicSharedMemorySize, LDS_BYTES) != hipSuccess) { fprintf(stderr, "kernel_launch: hipFuncSetAttribute failed\n"); grid = -1; return; }
        if (hipOccupancyMaxActiveBlocksPerMultiprocessor(&per_cu, (const void*)fwd, NWAVES * 64, LDS_BYTES) != hipSuccess || per_cu < 1) { fprintf(stderr, "kernel_launch: occupancy query reports %d\n", per_cu); }
        (void)hipGetLastError();
        grid = cus;
    }
    if (grid < 0) return;
    if (hipMemsetAsync((char*)d_ws + WS_CTL, 0, CTL_ZERO_BYTES, stream) != hipSuccess) return;
    Args a{};
    for (int i = 0; i < 12; ++i) a.in[i] = (const float*)d_in[i];
    a.out = (float*)d_out; a.ws = (unsigned char*)d_ws; a.pad = 0;
#if MK_N_LAUNCHES == 1
    a.ph_lo = 0; a.ph_hi = N_PHASES; a.li = 0;
    hipLaunchKernelGGL(fwd, dim3(grid), dim3(NWAVES * 64), LDS_BYTES, stream, a);
#else
    for (int p = 0; p < N_PHASES; ++p) { a.ph_lo = p; a.ph_hi = p + 1; a.li = 0; hipLaunchKernelGGL(fwd, dim3(grid), dim3(NWAVES * 64), LDS_BYTES, stream, a); }
#endif
}
```

```cpp
#include <hip/hip_runtime.h>
#include <cstdio>
#include <cstdint>

namespace pg8 {
#define PG8_LAS __attribute__((address_space(3)))
typedef unsigned short bf16_t;
typedef short bf16x8 __attribute__((ext_vector_type(8)));
typedef _Float16 f16x8 __attribute__((ext_vector_type(8)));
typedef float f32x4 __attribute__((ext_vector_type(4)));
typedef float f32x2 __attribute__((ext_vector_type(2)));
typedef unsigned u32x4 __attribute__((ext_vector_type(4)));
typedef unsigned u32x2 __attribute__((ext_vector_type(2)));
typedef int i32x4 __attribute__((ext_vector_type(4)));
typedef int i32x8 __attribute__((ext_vector_type(8)));
constexpr int BM = 256, BK = 64, HALF = 128, HTB = HALF * BK * 2, STAGE_BYTES = 8 * HTB, NXCD = 8, WGM = 8;

__host__ __device__ __forceinline__ int lds_byte(int r, int c) { const int st = (r >> 4) * 2 + (c >> 5), rr = r & 15, cc = c & 31, ob = rr * 64 + cc * 2; return st * 1024 + (ob ^ (((ob >> 9) & 1) << 5)); }
__host__ __device__ __forceinline__ void stage_rc(int b, int& R, int& C) { const int st = b / 1024, sb = b % 1024, swz = sb ^ (((sb >> 9) & 1) << 5); R = (st >> 1) * 16 + swz / 64; C = (st & 1) * 32 + (swz % 64) / 2; }
__host__ __device__ __forceinline__ int perm32(int rho) { const int n = rho >> 4, i = rho & 15; return 8 * (i >> 2) + 4 * n + (i & 3); }

struct Unit { int pm, pn; };
struct Gemm { const bf16_t* A; const bf16_t* Bt; int M, N, K; };

struct StaticOrder {
    int nM, nN, nwg, G, c, wgm;
    __host__ __device__ void init(int M, int N, int G_, int c_, int wgm_ = WGM) { nM = M / BM; nN = N / BM; nwg = nM * nN; G = G_; c = c_; wgm = wgm_; }
    __host__ __device__ bool next(int i, Unit& u) const {
        const long L = (long)i * G + c; if (L >= nwg) return false;
        int wgid = (int)L; { const int q = nwg / NXCD, r = nwg % NXCD, xcd = wgid % NXCD, off = wgid / NXCD; wgid = (xcd < r ? xcd * (q + 1) : r * (q + 1) + (xcd - r) * q) + off; }
        const int nig = wgm * nN, gid = wgid / nig, fm = gid * wgm, gsz = (nM - fm) < wgm ? (nM - fm) : wgm;
        u.pm = fm + ((wgid % nig) % gsz); u.pn = (wgid % nig) / gsz; return true;
    }
    __device__ __forceinline__ void a_ready(const Unit&) const {}
    __device__ __forceinline__ void done(const Unit&) const {}
};
typedef __bf16 bf16x2_t __attribute__((ext_vector_type(2)));
__device__ __forceinline__ unsigned cvt_pk_bf16(float lo, float hi) { f32x2 v = {lo, hi}; return __builtin_bit_cast(unsigned, __builtin_convertvector(v, bf16x2_t)); }
__device__ __forceinline__ unsigned cvt_pk_f16(float lo, float hi) { typedef _Float16 h2 __attribute__((ext_vector_type(2))); h2 v; v.x = (_Float16)lo; v.y = (_Float16)hi; return __builtin_bit_cast(unsigned, v); }
__device__ __forceinline__ float bf_lo(unsigned w) { return __builtin_bit_cast(float, w << 16); }
__device__ __forceinline__ float bf_hi(unsigned w) { return __builtin_bit_cast(float, w & 0xffff0000u); }

template <class Epi, class Sched, int MT  , bool ALIGN_EPI = true, bool SP2 = true>
__device__ __forceinline__ void gemm_phase(PG8_LAS unsigned char* lds, const Gemm g, const Sched& S, const Epi& E) {
    int tid_ = threadIdx.x; asm volatile("" : "+v"(tid_));
    const int tid = tid_, wid = __builtin_amdgcn_readfirstlane(tid >> 6), lane = tid & 63, wr = wid >> 2, wc = wid & 3, fr = lane & 15, fq = lane >> 4;
    const int K = g.K, nt = K / BK;
    unsigned voffA[2], voffB[2];
#pragma unroll
    for (int i = 0; i < 2; ++i) { int R, C; stage_rc(tid * 16 + i * 8192, R, C); const int Rb = Epi::PERM ? ((R & ~31) + perm32(R & 31)) : R;
        voffA[i] = (unsigned)(R * K + C) * 2u; voffB[i] = (unsigned)(Rb * K + C) * 2u; }
    const size_t kstep = (size_t)(BK * 2);
    const size_t hstep = (size_t)HALF * K * 2;
    const size_t tstep = 2 * hstep;
    const unsigned ldsw = (unsigned)wid * 1024u;
    const int aoff = lds_byte(wr * 64 + fr, fq * 8), boff = lds_byte(wc * 32 + fr, fq * 8);
#define PG8_SA(b, h) (((b) * 2 + (h)) * HTB)
#define PG8_SB(b, h) ((4 + (b) * 2 + (h)) * HTB)
#define PG8_STAGE(bufoff, gbase, voff) do { _Pragma("unroll") for (int _i = 0; _i < 2; ++_i) \
        __builtin_amdgcn_global_load_lds((const unsigned*)((const char*)(gbase) + (voff)[_i]), (PG8_LAS unsigned*)(lds + (bufoff) + ldsw + _i * 8192), 16, 0, 0); } while (0)
#define PG8_LDA(dst, b, h) do { _Pragma("unroll") for (int m = 0; m < 4; ++m) _Pragma("unroll") for (int k = 0; k < 2; ++k) dst[m][k] = *(const PG8_LAS bf16x8*)(lds + PG8_SA(b, h) + aoff + m * 2048 + k * 1024); } while (0)
#define PG8_LDB(dst, b, h) do { _Pragma("unroll") for (int n = 0; n < 2; ++n) _Pragma("unroll") for (int k = 0; k < 2; ++k) dst[n][k] = *(const PG8_LAS bf16x8*)(lds + PG8_SB(b, h) + boff + n * 2048 + k * 1024); } while (0)
#define PG8_MMA(ai, bj, At, Bt) do { __builtin_amdgcn_s_setprio(1); _Pragma("unroll") for (int m = 0; m < 4; ++m) _Pragma("unroll") for (int n = 0; n < 2; ++n) { \
        if constexpr (MT == 2) {   \
            const i32x8 b8_ = __builtin_shufflevector(__builtin_bit_cast(i32x4, Bt[n][0]), __builtin_bit_cast(i32x4, Bt[n][1]), 0, 1, 2, 3, 4, 5, 6, 7); \
            const i32x8 a8_ = __builtin_shufflevector(__builtin_bit_cast(i32x4, At[m][0]), __builtin_bit_cast(i32x4, At[m][1]), 0, 1, 2, 3, 4, 5, 6, 7); \
              \
            asm volatile("v_mfma_scale_f32_16x16x128_f8f6f4 %0, %1, %2, %0, %3, %3 op_sel_hi:[0,0,0]" : "+v"(acc[ai][bj][m][n]) : "v"(b8_), "v"(a8_), "v"(0x7f7f7f7f)); } \
        else { _Pragma("unroll") for (int k = 0; k < 2; ++k) { \
        if constexpr (MT == 1) acc[ai][bj][m][n] = __builtin_amdgcn_mfma_f32_16x16x32_f16(__builtin_bit_cast(f16x8, Bt[n][k]), __builtin_bit_cast(f16x8, At[m][k]), acc[ai][bj][m][n], 0, 0, 0); \
        else acc[ai][bj][m][n] = __builtin_amdgcn_mfma_f32_16x16x32_bf16(Bt[n][k], At[m][k], acc[ai][bj][m][n], 0, 0, 0); } } } __builtin_amdgcn_s_setprio(0); } while (0)
#define PG8_WAIT_V(n) asm volatile("s_waitcnt vmcnt(" #n ")" ::: "memory")
#define PG8_WAIT_L(n) asm volatile("s_waitcnt lgkmcnt(" #n ")" ::: "memory")
#define PG8_BAR __builtin_amdgcn_s_barrier()
#define PG8_SCHED __builtin_amdgcn_sched_barrier(0)
    Unit cur, nxt; int ui = 0;
    if (!S.next(0, cur)) return;
    f32x4 acc[2][2][4][2];
#pragma unroll
    for (int a = 0; a < 2; ++a)
#pragma unroll
        for (int b = 0; b < 2; ++b)
#pragma unroll
            for (int m = 0; m < 4; ++m)
#pragma unroll
                for (int n = 0; n < 2; ++n) acc[a][b][m][n] = (f32x4){0.f, 0.f, 0.f, 0.f};
    bf16x8 At[4][2], B0[2][2], B1[2][2];
    const char* cA = (const char*)g.A + (size_t)cur.pm * tstep; const char* cB = (const char*)g.Bt + (size_t)cur.pn * tstep;
    S.a_ready(cur);
    if constexpr (SP2) {
        PG8_STAGE(PG8_SB(0, 0), cB, voffB); PG8_STAGE(PG8_SB(0, 1), cB + hstep, voffB); PG8_STAGE(PG8_SA(0, 0), cA, voffA); PG8_STAGE(PG8_SA(0, 1), cA + hstep, voffA);
        if (wr == 1) PG8_BAR;
        PG8_WAIT_V(2); PG8_BAR;
        PG8_STAGE(PG8_SB(1, 0), cB + kstep, voffB); PG8_STAGE(PG8_SA(1, 0), cA + kstep, voffA); PG8_STAGE(PG8_SB(1, 1), cB + hstep + kstep, voffB);
        PG8_WAIT_V(6); PG8_BAR;
    } else {
        PG8_STAGE(PG8_SB(0, 0), cB, voffB); PG8_STAGE(PG8_SA(0, 0), cA, voffA); PG8_STAGE(PG8_SB(0, 1), cB + hstep, voffB); PG8_STAGE(PG8_SA(0, 1), cA + hstep, voffA);
        if (wr == 1) PG8_BAR;
        PG8_WAIT_V(4); PG8_BAR;
        PG8_STAGE(PG8_SB(1, 0), cB + kstep, voffB); PG8_STAGE(PG8_SA(1, 0), cA + kstep, voffA); PG8_STAGE(PG8_SB(1, 1), cB + hstep + kstep, voffB);
        PG8_WAIT_V(6); PG8_BAR;
    }
    for (;;) {
        const bool has_next = S.next(ui + 1, nxt);
        const char* nA = has_next ? (const char*)g.A + (size_t)nxt.pm * tstep : cA; const char* nB = has_next ? (const char*)g.Bt + (size_t)nxt.pn * tstep : cB;
        for (int t = 0; t < nt; t += 2) {
            const bool last = (t == nt - 2);
            const char* a1 = cA + (size_t)(t + 1) * kstep;
            const char* a2 = last ? nA : cA + (size_t)(t + 2) * kstep; const char* b2 = last ? nB : cB + (size_t)(t + 2) * kstep;
            const char* a3 = a2 + kstep; const char* b3 = b2 + kstep;
            if (last && has_next) S.a_ready(nxt);
            if constexpr (SP2) {
            PG8_LDB(B0, 0, 0); PG8_LDB(B1, 0, 1); PG8_SCHED; PG8_LDA(At, 0, 0); PG8_STAGE(PG8_SA(1, 1), a1 + hstep, voffA);
            PG8_WAIT_V(8); PG8_WAIT_L(0); PG8_BAR; PG8_MMA(0, 0, At, B0); PG8_MMA(0, 1, At, B1); PG8_BAR; PG8_SCHED;
            PG8_LDA(At, 0, 1); PG8_STAGE(PG8_SB(0, 0), b2, voffB); PG8_STAGE(PG8_SB(0, 1), b2 + hstep, voffB); PG8_STAGE(PG8_SA(0, 0), a2, voffA);
            PG8_WAIT_V(8); PG8_WAIT_L(0); PG8_BAR; PG8_MMA(1, 0, At, B0); PG8_MMA(1, 1, At, B1); PG8_BAR; PG8_SCHED;
            PG8_LDB(B0, 1, 0); PG8_LDB(B1, 1, 1); PG8_SCHED; PG8_LDA(At, 1, 0); PG8_STAGE(PG8_SA(0, 1), a2 + hstep, voffA);
            PG8_WAIT_V(8); PG8_WAIT_L(0); PG8_BAR; PG8_MMA(0, 0, At, B0); PG8_MMA(0, 1, At, B1); PG8_BAR; PG8_SCHED;
            PG8_LDA(At, 1, 1); PG8_STAGE(PG8_SB(1, 0), b3, voffB); PG8_STAGE(PG8_SB(1, 1), b3 + hstep, voffB); PG8_STAGE(PG8_SA(1, 0), a3, voffA);
            PG8_WAIT_V(8); PG8_WAIT_L(0); PG8_BAR; PG8_MMA(1, 0, At, B0); PG8_MMA(1, 1, At, B1); PG8_BAR; PG8_SCHED;
            } else {
            PG8_LDB(B0, 0, 0); PG8_SCHED; PG8_LDA(At, 0, 0); PG8_STAGE(PG8_SA(1, 1), a1 + hstep, voffA);
            PG8_WAIT_L(8); PG8_BAR; PG8_WAIT_L(0); PG8_MMA(0, 0, At, B0); PG8_BAR; PG8_SCHED;
            PG8_LDB(B1, 0, 1); PG8_STAGE(PG8_SB(0, 0), b2, voffB);
            PG8_BAR; PG8_WAIT_L(0); PG8_MMA(0, 1, At, B1); PG8_BAR;
            PG8_LDA(At, 0, 1); PG8_STAGE(PG8_SA(0, 0), a2, voffA);
            PG8_BAR; PG8_WAIT_L(0); PG8_MMA(1, 0, At, B0); PG8_BAR; PG8_SCHED;
            PG8_STAGE(PG8_SB(0, 1), b2 + hstep, voffB);
            PG8_WAIT_V(6); PG8_BAR; PG8_MMA(1, 1, At, B1); PG8_BAR;
            PG8_LDB(B0, 1, 0); PG8_SCHED; PG8_LDA(At, 1, 0); PG8_STAGE(PG8_SA(0, 1), a2 + hstep, voffA);
            PG8_WAIT_L(8); PG8_BAR; PG8_WAIT_L(0); PG8_MMA(0, 0, At, B0); PG8_BAR; PG8_SCHED;
            PG8_LDB(B1, 1, 1); PG8_STAGE(PG8_SB(1, 0), b3, voffB);
            PG8_BAR; PG8_WAIT_L(0); PG8_MMA(0, 1, At, B1); PG8_BAR;
            PG8_LDA(At, 1, 1); PG8_STAGE(PG8_SA(1, 0), a3, voffA);
            PG8_BAR; PG8_WAIT_L(0); PG8_MMA(1, 0, At, B0); PG8_BAR; PG8_SCHED;
            PG8_STAGE(PG8_SB(1, 1), b3 + hstep, voffB);
            PG8_WAIT_V(6); PG8_BAR; PG8_MMA(1, 1, At, B1); PG8_BAR;
            }
        }
        if constexpr (ALIGN_EPI) { if (wr == 0) PG8_BAR; }
        if constexpr (MT == 2) asm volatile("s_nop 15\n\ts_nop 15\n\ts_nop 15" ::: "memory");
        E(acc, cur, wr, wc, fr, fq);
        if (!has_next) break;
#pragma unroll
        for (int a = 0; a < 2; ++a)
#pragma unroll
            for (int b = 0; b < 2; ++b)
#pragma unroll
                for (int m = 0; m < 4; ++m)
#pragma unroll
                    for (int n = 0; n < 2; ++n) acc[a][b][m][n] = (f32x4){0.f, 0.f, 0.f, 0.f};
        cur = nxt; cA = nA; cB = nB; ++ui;
        if constexpr (ALIGN_EPI) { if (wr == 1) PG8_BAR; }
    }
    PG8_WAIT_V(0);
    if constexpr (!ALIGN_EPI) { if (wr == 0) PG8_BAR; }
    PG8_BAR;
#undef PG8_SA
#undef PG8_SB
#undef PG8_STAGE
#undef PG8_LDA
#undef PG8_LDB
#undef PG8_MMA
#undef PG8_WAIT_V
#undef PG8_WAIT_L
#undef PG8_BAR
#undef PG8_SCHED
}
}

constexpr int NWAVES = 8;
constexpr int BATCH = 2, SEQ = 8192, DM = 4096, M = BATCH * SEQ;
constexpr int HD = 128, NH = 16, DA = 2048, NIH = 32, IDIM = 64, DFF = 16384, TOPK = 256, CHUNK = 64, NCHUNK = SEQ / CHUNK;
constexpr int DIN = 22640, NPAD = 22784;
constexpr float EPS = 1e-6f;
constexpr float ATT_SCALE = 0.08838834764831845f;
constexpr float IW_SCALE = 0.125f * 0.17677669529663687f;
constexpr int SRC_QA = 0, SRC_KA = 2048, SRC_VA = 4096, SRC_IQ = 6144, SRC_IK = 8192, SRC_IW = 8256, SRC_QB = 8288, SRC_KB = 10336, SRC_VB = 12384, SRC_FL = 14432, SRC_GA = 14448, SRC_GB = 18544;
constexpr int DST_QKV = 0, DST_G = 12288, DST_IQ = 20480, DST_SP = 22528;
constexpr int TILE_G0 = DST_G / 256, TILE_IQ0 = DST_IQ / 256, TILE_SP = DST_SP / 256;

constexpr size_t MiB = 1u << 20;
constexpr size_t WS_CTL = 0, CTL_ZERO_BYTES = 64 * 1024;
constexpr size_t WS_MASK = 1 * MiB;
constexpr size_t WS_CUM = 17 * MiB;
constexpr size_t WS_MISC = 18 * MiB;
constexpr size_t WS_NORM = 19 * MiB;
constexpr size_t WS_CD = 20 * MiB;
constexpr size_t WS_WIN8 = WS_CD, WS_WINH = WS_CD + 80 * MiB, WS_XN8 = WS_CD + 98 * MiB, WS_XN = WS_CD + 162 * MiB, WS_SCORE = WS_CD, WS_WDN = WS_CD + 128 * MiB;
constexpr size_t WS_SSP = 280 * MiB, WS_RSTD = 284 * MiB;
constexpr size_t WS_B = 326 * MiB;
constexpr size_t WS_WOA = WS_B, WS_WOB = WS_B + 16 * MiB, WS_WO = WS_B + 32 * MiB;
constexpr size_t WS_E = 390 * MiB;
constexpr size_t ACT2K = 64 * MiB;
constexpr size_t WS_T = WS_E + 2 * ACT2K, WS_MERGED = WS_E + 4 * ACT2K;
constexpr size_t WS_F = 774 * MiB;
constexpr size_t WS_IQ = WS_F, WS_IK = WS_F + 64 * MiB, WS_IW = WS_F + 66 * MiB, WS_FL = WS_F + 68 * MiB;
constexpr size_t WS_H = WS_B;
constexpr size_t WS_G = 846 * MiB;
constexpr size_t WS_GA = WS_G, WS_GB = WS_G + 64 * MiB, WS_X2B = WS_G, WS_Y8A = WS_G + 128 * MiB, WS_Y8B = WS_G + 160 * MiB;
constexpr size_t WS_X1B = 1102 * MiB;
constexpr size_t WS_WUP = 1230 * MiB;
constexpr size_t WS_END = 1358 * MiB;
constexpr int UP_EARLY_PER_WAVE = 7;
static_assert(WS_H + (size_t)M * DFF * 2 <= WS_G && WS_F + 72 * MiB <= WS_G && WS_SCORE + 280 * MiB <= WS_B, "ws map");
constexpr int CW_TMO = 0, CW_BAR = 4096;
constexpr int CW_RSS1 = 16384, CW_RSS2 = 32768;

constexpr int RING_OFF = 0, RING_BYTES = 131072;
constexpr int LDSCTL_OFF = 143360, MISC_OFF = LDSCTL_OFF + 320;
constexpr int LDS_BYTES = 147456;

#define GAS __attribute__((address_space(1)))
#define LAS __attribute__((address_space(3)))
typedef unsigned short bf16;
typedef unsigned v4u __attribute__((ext_vector_type(4)));
typedef float f32x4 __attribute__((ext_vector_type(4)));
typedef float f32x16 __attribute__((ext_vector_type(16)));
typedef _Float16 f16x8 __attribute__((ext_vector_type(8)));
typedef GAS unsigned gu32;
#define RLX_AGENT __ATOMIC_RELAXED, __HIP_MEMORY_SCOPE_AGENT
#define LDS_WAIT() asm volatile("s_waitcnt lgkmcnt(0)" ::: "memory")
#define VM_WAIT() asm volatile("s_waitcnt vmcnt(0)" ::: "memory")
__device__ __forceinline__ unsigned f2bf(float f) { unsigned u = __builtin_bit_cast(unsigned, f); return (u + 0x7fffu + ((u >> 16) & 1u)) >> 16; }
__device__ __forceinline__ unsigned pk2bf(float lo, float hi) { return f2bf(lo) | (f2bf(hi) << 16); }
__device__ __forceinline__ unsigned pk2h(float lo, float hi) { return pg8::cvt_pk_f16(lo, hi); }
__device__ __forceinline__ float bf2f(bf16 b) { return __builtin_bit_cast(float, ((unsigned)b) << 16); }

#define XB_TMO      128
#define XB_XCNT(j)  (256  + 64 * (j))
#define XB_XSUB(j)  (1280 + 64 * (j))
#define XB_XGEN(j)  (2304 + 64 * (j))
#define XB_TOP      3328
#define XB_TOPGEN   3392
#define XCD_BAR_WORDS 3456
#define XB_SPIN_CAP (1u << 22)
__device__ __forceinline__ unsigned xb_ld(unsigned* p)              { return __hip_atomic_load(p, __ATOMIC_RELAXED, __HIP_MEMORY_SCOPE_AGENT); }
__device__ __forceinline__ unsigned xb_add(unsigned* p, unsigned v) { return __hip_atomic_fetch_add(p, v, __ATOMIC_RELAXED, __HIP_MEMORY_SCOPE_AGENT); }
__device__ __forceinline__ unsigned xb_xcc_id() { return (unsigned)__builtin_amdgcn_s_getreg((3 << 11) | 20) & 0xFu; }
#define XB_SPIN(cond, bar) do { unsigned _sp = 0; while (cond) { __builtin_amdgcn_s_sleep(1); \
    if ((++_sp & 255u) == 0u) { if (xb_ld(&(bar)[XB_TMO])) break; if (_sp > XB_SPIN_CAP) { atomicAdd(&(bar)[XB_TMO], 1u); break; } } } } while (0)
struct XcdBarrier { unsigned* bar; unsigned x; volatile LAS unsigned* st; };
__device__ __forceinline__ XcdBarrier xcd_barrier_post(unsigned* bar, volatile LAS unsigned* st) {
    XcdBarrier b; b.bar = bar; b.x = xb_xcc_id(); b.st = st;
    if (threadIdx.x == 0) (void)xb_add(&bar[XB_XCNT(b.x)], 1u);
    return b;
}
__device__ __forceinline__ void xcd_barrier_complete(unsigned* bar, unsigned x, unsigned& nloc, unsigned& nx) {
    const unsigned G = gridDim.x * gridDim.y * gridDim.z;
    unsigned sum, cnt, mine, sp = 0u;
    for (;;) {
        sum = 0u; cnt = 0u; mine = 0u;
#pragma unroll
        for (unsigned j = 0; j < 16; ++j) { const unsigned c = xb_ld(&bar[XB_XCNT(j)]); sum += c; cnt += (c > 0u) ? 1u : 0u; mine = (j == x) ? c : mine; }
        if (sum == G) break;
        __builtin_amdgcn_s_sleep(1);
        if ((++sp & 255u) == 0u) { if (xb_ld(&bar[XB_TMO])) break; if (sp > XB_SPIN_CAP) { atomicAdd(&bar[XB_TMO], 1u); break; } }
    }
    nloc = mine > 0u ? mine : 1u; nx = cnt > 0u ? cnt : 1u;
}
__device__ __forceinline__ void xcd_barrier(const XcdBarrier& b) {
    asm volatile("s_waitcnt vmcnt(0)" ::: "memory");
    __syncthreads();
    if (threadIdx.x == 0) {
        unsigned* bar = b.bar;
        __builtin_amdgcn_s_waitcnt(0);
        unsigned nloc = b.st[0], nx = b.st[1];
        if (nloc == 0u) { xcd_barrier_complete(bar, b.x, nloc, nx); b.st[0] = nloc; b.st[1] = nx; }
        const unsigned old = xb_add(&bar[XB_XSUB(b.x)], 1u);
        const unsigned gen = old / nloc;
        if (old + 1u == (gen + 1u) * nloc) {
            __builtin_amdgcn_fence(__ATOMIC_RELEASE, "agent");
            asm volatile("s_waitcnt vmcnt(0)" ::: "memory");
            const unsigned og = xb_add(&bar[XB_TOP], 1u);
            const unsigned tg = og / nx;
            if (og + 1u == (tg + 1u) * nx) xb_add(&bar[XB_TOPGEN], 1u);
            else XB_SPIN(xb_ld(&bar[XB_TOPGEN]) == tg, bar);
            __builtin_amdgcn_fence(__ATOMIC_ACQUIRE, "agent");
            xb_add(&bar[XB_XGEN(b.x)], 1u);
            asm volatile("s_waitcnt vmcnt(0)" ::: "memory");
        } else {
            XB_SPIN(xb_ld(&bar[XB_XGEN(b.x)]) == gen, bar);
            __builtin_amdgcn_fence(__ATOMIC_ACQUIRE, "agent");
            asm volatile("s_waitcnt vmcnt(0)" ::: "memory");
        }
    }
    __syncthreads();
}

struct Frame {
    LAS unsigned char* lds;
    volatile LAS unsigned* MISC;
    gu32* ctl;
    int tid, lane, wave, vcu, G;
    unsigned char* ws;
    const float *x, *w_in, *b_f, *w_out_a, *w_out_b, *w_o, *w_up, *w_down, *g_mix, *g_mlp, *g_final, *rel_bias;
    float* out;
};
__device__ __forceinline__ float wave_sum(float v) {
#pragma unroll
    for (int o = 1; o < 64; o <<= 1) v += __shfl_xor(v, o);
    return v;
}

template <bool F16>
__device__ __forceinline__ void transpose_item(const float* W, int K, int N, bf16* WT, int k0, int scol, int nvalid, int drow, const float* kscale, LAS float* scr, int lane) {
#pragma unroll 8
    for (int i = 0; i < 32; ++i) { const int kk = 2 * i + (lane >> 5); const int c = lane & 31;
        float v = (c < nvalid) ? W[(size_t)(k0 + kk) * N + scol + c] : 0.f; if (kscale) v *= kscale[k0 + kk]; scr[kk * 33 + c] = v; }
    LDS_WAIT(); asm volatile("" ::: "memory");
    const int c = lane & 7;
#pragma unroll
    for (int j = 0; j < 4; ++j) { const int n = (lane >> 3) + 8 * j; const LAS float* s = scr + (8 * c) * 33 + n;
        v4u o;
        if constexpr (F16) { o.x = pk2h(s[0 * 33], s[1 * 33]); o.y = pk2h(s[2 * 33], s[3 * 33]); o.z = pk2h(s[4 * 33], s[5 * 33]); o.w = pk2h(s[6 * 33], s[7 * 33]); }
        else { o.x = pk2bf(s[0 * 33], s[1 * 33]); o.y = pk2bf(s[2 * 33], s[3 * 33]); o.z = pk2bf(s[4 * 33], s[5 * 33]); o.w = pk2bf(s[6 * 33], s[7 * 33]); }
        *(GAS v4u*)(WT + (size_t)(drow + n) * K + k0 + 8 * c) = o; }
    LDS_WAIT(); asm volatile("" ::: "memory");
}
struct TpJob { const float* W; bf16* WT; int K, N, k0, scol, drow, f16; const float* ks; };
__device__ __forceinline__ void tp_load(const TpJob& J, f32x4 (&v)[16], int lane) {
    const float* p = J.W + (size_t)(J.k0 + (lane >> 4)) * J.N + J.scol + 4 * (lane & 15);
#pragma unroll
    for (int i = 0; i < 16; ++i) v[i] = *(const f32x4*)(p + (size_t)(4 * i) * J.N);
}
__device__ __forceinline__ void tp_store(const TpJob& J, const f32x4 (&v)[16], LAS float* scr, int lane) {
    { LAS float* d = scr + (lane >> 4) * 65 + 4 * (lane & 15);
#pragma unroll
      for (int i = 0; i < 16; ++i) { d[(4 * i) * 65 + 0] = v[i][0]; d[(4 * i) * 65 + 1] = v[i][1]; d[(4 * i) * 65 + 2] = v[i][2]; d[(4 * i) * 65 + 3] = v[i][3]; } }
    LDS_WAIT(); asm volatile("" ::: "memory");
    const int nl = lane >> 3, kc = lane & 7;
#pragma unroll
    for (int j = 0; j < 8; ++j) { const int n = nl + 8 * j; const LAS float* q = scr + (8 * kc) * 65 + n;
        v4u o;
        if (J.f16 == 1) { o.x = pk2h(q[0 * 65], q[1 * 65]); o.y = pk2h(q[2 * 65], q[3 * 65]); o.z = pk2h(q[4 * 65], q[5 * 65]); o.w = pk2h(q[6 * 65], q[7 * 65]); }
        else if (J.ks) { const f32x4 s0 = *(const f32x4*)(J.ks + J.k0 + 8 * kc), s1 = *(const f32x4*)(J.ks + J.k0 + 8 * kc + 4);
            o.x = pg8::cvt_pk_bf16(q[0 * 65] * s0[0], q[1 * 65] * s0[1]); o.y = pg8::cvt_pk_bf16(q[2 * 65] * s0[2], q[3 * 65] * s0[3]); o.z = pg8::cvt_pk_bf16(q[4 * 65] * s1[0], q[5 * 65] * s1[1]); o.w = pg8::cvt_pk_bf16(q[6 * 65] * s1[2], q[7 * 65] * s1[3]); }
        else { o.x = pg8::cvt_pk_bf16(q[0 * 65], q[1 * 65]); o.y = pg8::cvt_pk_bf16(q[2 * 65], q[3 * 65]); o.z = pg8::cvt_pk_bf16(q[4 * 65], q[5 * 65]); o.w = pg8::cvt_pk_bf16(q[6 * 65], q[7 * 65]); }
        if (J.f16 == 2) {
            int p0 = __builtin_amdgcn_cvt_pk_fp8_f32(q[0 * 65] * 64.f, q[1 * 65] * 64.f, 0, false); p0 = __builtin_amdgcn_cvt_pk_fp8_f32(q[2 * 65] * 64.f, q[3 * 65] * 64.f, p0, true);
            int p1 = __builtin_amdgcn_cvt_pk_fp8_f32(q[4 * 65] * 64.f, q[5 * 65] * 64.f, 0, false); p1 = __builtin_amdgcn_cvt_pk_fp8_f32(q[6 * 65] * 64.f, q[7 * 65] * 64.f, p1, true);
            *(GAS unsigned long long*)((GAS unsigned char*)J.WT + (size_t)(J.drow + n) * J.K + J.k0 + 8 * kc) = (unsigned long long)(unsigned)p0 | ((unsigned long long)(unsigned)p1 << 32); }
        else *(GAS v4u*)(J.WT + (size_t)(J.drow + n) * J.K + J.k0 + 8 * kc) = o; }
    LDS_WAIT(); asm volatile("" ::: "memory");
}
template <class Decode>
__device__ __forceinline__ void tp_run(Frame& F, int nitems, const Decode& dec, int gw, int NGW) {
    LAS float* scr = (LAS float*)(F.lds + RING_OFF + F.wave * 16640);
    f32x4 va[16], vb[16]; TpJob ja, jb;
    int it = gw; if (it >= nitems) return;
    ja = dec(it); tp_load(ja, va, F.lane);
    for (;;) {
        const int i1 = it + NGW; const bool h1 = i1 < nitems;
        if (h1) { jb = dec(i1); tp_load(jb, vb, F.lane); }
        tp_store(ja, va, scr, F.lane);
        if (!h1) break;
        const int i2 = i1 + NGW; const bool h2 = i2 < nitems;
        if (h2) { ja = dec(i2); tp_load(ja, va, F.lane); }
        tp_store(jb, vb, scr, F.lane);
        if (!h2) break;
        it = i2;
    }
}
__device__ __forceinline__ void win_group(int gi, int& scol, int& nvalid) {
    const int d = gi * 32; nvalid = 32;
    if (d < DST_G) { const int t = d / 2048, o = d % 2048; const int base = (t == 0) ? SRC_QA : (t == 1) ? SRC_QB : (t == 2) ? SRC_KA : (t == 3) ? SRC_VA : (t == 4) ? SRC_KB : SRC_VB; scol = base + o; }
    else if (d < DST_IQ) { const int o = d - DST_G; scol = (o < 4096) ? SRC_GA + o : SRC_GB + (o - 4096); }
    else if (d < DST_SP) { scol = SRC_IQ + (d - DST_IQ); }
    else { const int o = d - DST_SP; if (o < 64) scol = SRC_IK + o; else if (o < 96) scol = SRC_IW + (o - 64); else if (o < 128) { scol = SRC_FL; nvalid = 16; } else { scol = 0; nvalid = 0; } }
}
__device__ __forceinline__ void p0_prologue(Frame& F) {
    const int gw = F.vcu * NWAVES + F.wave, NGW = F.G * NWAVES;
    constexpr int G8 = DST_IQ / 64, GH = (DST_SP - DST_IQ) / 64 + 1;
    constexpr int I8 = (DM / 64) * G8, IH = (DM / 64) * GH;
    const float* w_in = F.w_in; unsigned char* ws = F.ws;
    tp_run(F, I8 + IH, [=](int r) {
        TpJob J; int scol, nv;
        if (r < I8) { const int gi = r % G8, kb = r / G8; win_group(2 * gi, scol, nv); J = TpJob{w_in, (bf16*)(ws + WS_WIN8), DM, DIN, 64 * kb, scol, 64 * gi, 2, nullptr}; return J; } r -= I8;
        { const int gi = r % GH, kb = r / GH; win_group(2 * (G8 + gi), scol, nv); J = TpJob{w_in, (bf16*)(ws + WS_WINH), DM, DIN, 64 * kb, scol, 64 * gi, 1, nullptr}; return J; }
    }, gw, NGW);
    { LAS float* scr = (LAS float*)(F.lds + RING_OFF + F.wave * 16640);
      for (int it = gw; it < 6 * (DM / 64); it += NGW) { const int gi = (DST_SP + 64) / 32 + it % 6, kb = it / 6; int scol, nv; win_group(gi, scol, nv);
          transpose_item<true>(F.w_in, DM, DIN, (bf16*)(F.ws + WS_WINH), 64 * kb, scol, nv, gi * 32 - DST_IQ, nullptr, scr, F.lane); } }
    for (int m = gw; m < M; m += NGW) {
        const GAS f32x4* xr = (const GAS f32x4*)(F.x + (size_t)m * DM) + F.lane;
        f32x4 v[16]; float s = 0.f;
#pragma unroll
        for (int j = 0; j < 16; ++j) { v[j] = xr[64 * j]; s += (v[j].x * v[j].x + v[j].y * v[j].y) + (v[j].z * v[j].z + v[j].w * v[j].w); }
        const float rstd = 1.0f / sqrtf(wave_sum(s) * (1.f / DM) + EPS);
        GAS unsigned long long* o8 = (GAS unsigned long long*)((bf16*)(F.ws + WS_XN) + (size_t)m * DM) + F.lane;
        const GAS f32x4* gr = (const GAS f32x4*)F.g_mix + F.lane;
        GAS unsigned* o4 = (GAS unsigned*)(F.ws + WS_XN8 + (size_t)m * DM) + F.lane;
#pragma unroll
        for (int j = 0; j < 16; ++j) { const f32x4 g = gr[64 * j];
            const float y0 = v[j].x * rstd * g.x, y1 = v[j].y * rstd * g.y, y2 = v[j].z * rstd * g.z, y3 = v[j].w * rstd * g.w;
            o8[64 * j] = (unsigned long long)pk2h(y0, y1) | ((unsigned long long)pk2h(y2, y3) << 32);
            int p8 = __builtin_amdgcn_cvt_pk_fp8_f32(y0, y1, 0, false); p8 = __builtin_amdgcn_cvt_pk_fp8_f32(y2, y3, p8, true);
            o4[64 * j] = (unsigned)p8; }
    }
}
__device__ __forceinline__ void p1_convert_small_weights(Frame& F, int widx, int nwg) {
    constexpr int I_OA = (DA / 64) * (DM / 64), I_O = (DM / 64) * (DM / 64);
    const float* w_oa = F.w_out_a; const float* w_ob = F.w_out_b; const float* w_o = F.w_o; unsigned char* ws = F.ws;
    tp_run(F, 2 * I_OA + I_O, [=](int r) {
        TpJob J;
        if (r < I_OA) { const int nb = r % (DM / 64), kb = r / (DM / 64); J = TpJob{w_oa, (bf16*)(ws + WS_WOA), DA, DM, 64 * kb, 64 * nb, 64 * nb, 2, nullptr}; return J; } r -= I_OA;
        if (r < I_OA) { const int nb = r % (DM / 64), kb = r / (DM / 64); J = TpJob{w_ob, (bf16*)(ws + WS_WOB), DA, DM, 64 * kb, 64 * nb, 64 * nb, 2, nullptr}; return J; } r -= I_OA;
        { const int nb = r % (DM / 64), kb = r / (DM / 64); J = TpJob{w_o, (bf16*)(ws + WS_WO), DM, DM, 64 * kb, 64 * nb, 64 * nb, 2, nullptr}; return J; }
    }, widx * NWAVES + F.wave, nwg * NWAVES);
    { constexpr int I_UP = (DM / 64) * (DFF / 64); const int nearly = UP_EARLY_PER_WAVE * nwg * NWAVES, up_early = nearly < I_UP ? nearly : I_UP;
      const float* w_up = F.w_up; const float* gml = F.g_mlp;
      tp_run(F, up_early, [=](int r) { const int nb = r % (DFF / 64), kb = r / (DFF / 64); TpJob J{w_up, (bf16*)(ws + WS_WUP), DM, DFF, 64 * kb, 64 * nb, 64 * nb, 0, gml}; return J; }, widx * NWAVES + F.wave, nwg * NWAVES); }
}
__device__ __forceinline__ void p5_convert_mlp_weights(Frame& F, int up_early) {
    constexpr int I_UP = (DM / 64) * (DFF / 64), I_DN = (DFF / 64) * (DM / 64);
    const float* w_up = F.w_up; const float* w_dn = F.w_down; const float* gml = F.g_mlp; unsigned char* ws = F.ws;
    const int n_up = I_UP - up_early;
    tp_run(F, n_up + I_DN, [=](int r) {
        TpJob J;
        if (r < n_up) { const int q = r + up_early, nb = q % (DFF / 64), kb = q / (DFF / 64); J = TpJob{w_up, (bf16*)(ws + WS_WUP), DM, DFF, 64 * kb, 64 * nb, 64 * nb, 0, gml}; return J; } r -= n_up;
        { const int nb = r % (DM / 64), kb = r / (DM / 64); J = TpJob{w_dn, (bf16*)(ws + WS_WDN), DFF, DM, 64 * kb, 64 * nb, 64 * nb, 0, nullptr}; return J; }
    }, F.vcu * NWAVES + F.wave, F.G * NWAVES);
}

using pg8::f32x2; using pg8::u32x4; using pg8::Unit;
__device__ __forceinline__ float sigmoidf_fast(float x) { return __builtin_amdgcn_rcpf(1.0f + __expf(-x)); }
template <int PART  > struct EpiInProj {
    static constexpr bool PERM = true;
    unsigned char* ws; const float* b_f; int pn_off; float scale;
    __device__ __forceinline__ void operator()(const f32x4 (&acc)[2][2][4][2], const Unit& u, int wr, int wc, int fr, int fq) const {
        int row0 = u.pm * 256 + wr * 64 + fr; asm volatile("" : "+v"(row0));
        const int c8 = wc * 32 + 8 * fq, pn = u.pn + pn_off; const float sc = scale;
        if (PART == 0 && pn < TILE_G0 && ((pn >> 3) == 0 || (pn >> 3) == 2 || (pn >> 3) == 3)) {
            unsigned char* base = ws + WS_E + (size_t)(pn >> 3) * ACT2K + (pn & 7) * 256 + c8;
#pragma unroll
            for (int ai = 0; ai < 2; ++ai)
#pragma unroll
                for (int m = 0; m < 4; ++m) { unsigned char* rowp = base + (size_t)(row0 + ai * 128 + m * 16) * DA;
#pragma unroll
                    for (int bj = 0; bj < 2; ++bj) { const f32x4 v0 = acc[ai][bj][m][0] * sc, v1 = acc[ai][bj][m][1] * sc;
                        int p0 = __builtin_amdgcn_cvt_pk_fp8_f32(v0[0], v0[1], 0, false); p0 = __builtin_amdgcn_cvt_pk_fp8_f32(v0[2], v0[3], p0, true);
                        int p1 = __builtin_amdgcn_cvt_pk_fp8_f32(v1[0], v1[1], 0, false); p1 = __builtin_amdgcn_cvt_pk_fp8_f32(v1[2], v1[3], p1, true);
                        pg8::u32x2 w2; w2.x = (unsigned)p0; w2.y = (unsigned)p1; *(pg8::u32x2*)(rowp + bj * 128) = w2; } }
        } else if (PART == 0 && pn < TILE_G0) {
            bf16* base = (bf16*)(ws + WS_E) + (size_t)(pn >> 3) * ((size_t)M * DA) + (pn & 7) * 256 + c8;
#pragma unroll
            for (int ai = 0; ai < 2; ++ai)
#pragma unroll
                for (int m = 0; m < 4; ++m) { bf16* rowp = base + (size_t)(row0 + ai * 128 + m * 16) * DA;
#pragma unroll
                    for (int bj = 0; bj < 2; ++bj) { const f32x4 v0 = acc[ai][bj][m][0] * sc, v1 = acc[ai][bj][m][1] * sc;
                        u32x4 w; w.x = pg8::cvt_pk_bf16(v0[0], v0[1]); w.y = pg8::cvt_pk_bf16(v0[2], v0[3]); w.z = pg8::cvt_pk_bf16(v1[0], v1[1]); w.w = pg8::cvt_pk_bf16(v1[2], v1[3]);
                        *(u32x4*)(rowp + bj * 128) = w; } }
        } else if (PART == 0) {
            const int t = pn - TILE_G0;
            unsigned char* base = ws + WS_GA + (size_t)(t >> 4) * ((size_t)M * DM) + (t & 15) * 256 + c8;
#pragma unroll
            for (int ai = 0; ai < 2; ++ai)
#pragma unroll
                for (int m = 0; m < 4; ++m) { unsigned char* rowp = base + (size_t)(row0 + ai * 128 + m * 16) * DM;
#pragma unroll
                    for (int bj = 0; bj < 2; ++bj) { const f32x4 v0 = acc[ai][bj][m][0] * sc, v1 = acc[ai][bj][m][1] * sc;
                        unsigned p0 = __builtin_amdgcn_cvt_pk_u8_f32(sigmoidf_fast(v0[0]) * 255.f, 0, 0u); p0 = __builtin_amdgcn_cvt_pk_u8_f32(sigmoidf_fast(v0[1]) * 255.f, 1, p0);
                        p0 = __builtin_amdgcn_cvt_pk_u8_f32(sigmoidf_fast(v0[2]) * 255.f, 2, p0); p0 = __builtin_amdgcn_cvt_pk_u8_f32(sigmoidf_fast(v0[3]) * 255.f, 3, p0);
                        unsigned p1 = __builtin_amdgcn_cvt_pk_u8_f32(sigmoidf_fast(v1[0]) * 255.f, 0, 0u); p1 = __builtin_amdgcn_cvt_pk_u8_f32(sigmoidf_fast(v1[1]) * 255.f, 1, p1);
                        p1 = __builtin_amdgcn_cvt_pk_u8_f32(sigmoidf_fast(v1[2]) * 255.f, 2, p1); p1 = __builtin_amdgcn_cvt_pk_u8_f32(sigmoidf_fast(v1[3]) * 255.f, 3, p1);
                        pg8::u32x2 w2; w2.x = p0; w2.y = p1; *(pg8::u32x2*)(rowp + bj * 128) = w2; } }
        } else if (PART == 1 && pn < TILE_SP) {
            bf16* base = (bf16*)(ws + WS_IQ);
#pragma unroll
            for (int ai = 0; ai < 2; ++ai)
#pragma unroll
                for (int m = 0; m < 4; ++m) { bf16* rowp = base + (size_t)(row0 + ai * 128 + m * 16) * 2048;
#pragma unroll
                    for (int bj = 0; bj < 2; ++bj) { const f32x4 v0 = acc[ai][bj][m][0], v1 = acc[ai][bj][m][1];
                        const int col = (pn - TILE_IQ0) * 256 + bj * 128 + c8, hh = col >> 6, d0 = col & 63;
                        u32x4 w; w.x = pk2h(v0[0], v0[1]); w.y = pk2h(v0[2], v0[3]); w.z = pk2h(v1[0], v1[1]); w.w = pk2h(v1[2], v1[3]);
                        *(u32x4*)(rowp + (d0 >> 4) * 512 + (((d0 >> 3) & 1) * 32 + hh) * 8) = w; } }
        } else if (PART == 1) {
#pragma unroll
            for (int ai = 0; ai < 2; ++ai)
#pragma unroll
                for (int m = 0; m < 4; ++m) { const size_t r = (size_t)(row0 + ai * 128 + m * 16); const f32x4 v0 = acc[ai][0][m][0], v1 = acc[ai][0][m][1];
                    if (c8 < 64) { u32x4 w; w.x = pk2h(v0[0], v0[1]); w.y = pk2h(v0[2], v0[3]); w.z = pk2h(v1[0], v1[1]); w.w = pk2h(v1[2], v1[3]); *(u32x4*)((bf16*)(ws + WS_IK) + (r >> 5) * 2048 + (c8 >> 4) * 512 + (((c8 >> 3) & 1) * 32 + (r & 31)) * 8) = w; }
                    else if (c8 < 96) { float* p = (float*)(ws + WS_IW) + r * 32 + (c8 - 64); *(f32x4*)p = v0 * IW_SCALE; *(f32x4*)(p + 4) = v1 * IW_SCALE; }
                    else if (c8 < 112) { float* p = (float*)(ws + WS_FL) + r * 16 + (c8 - 96); f32x4 o0, o1;
#pragma unroll
                        for (int j = 0; j < 4; ++j) { const float a = v0[j] + b_f[c8 - 96 + j], b = v1[j] + b_f[c8 - 96 + 4 + j];
                            o0[j] = fminf(a, 0.f) - log1pf(expf(-fabsf(a))); o1[j] = fminf(b, 0.f) - log1pf(expf(-fabsf(b))); }
                        *(f32x4*)p = o0; *(f32x4*)(p + 4) = o1; } }
        }
    }
};
template <bool SECOND> struct EpiGate {
    static constexpr bool PERM = true;
    const unsigned char* gate; bf16* T; bf16* out; float sc;
    __device__ __forceinline__ void operator()(const f32x4 (&acc)[2][2][4][2], const Unit& u, int wr, int wc, int fr, int fq) const {
        const int row0 = u.pm * 256 + wr * 64 + fr, col0 = u.pn * 256 + wc * 32 + 8 * fq;
#pragma unroll
        for (int ai = 0; ai < 2; ++ai)
#pragma unroll
            for (int m = 0; m < 4; ++m) { const size_t ro = (size_t)(row0 + ai * 128 + m * 16) * DM + col0;
#pragma unroll
                for (int bj = 0; bj < 2; ++bj) { const f32x4 v0 = acc[ai][bj][m][0], v1 = acc[ai][bj][m][1];
                    const pg8::u32x2 gv = *(const pg8::u32x2*)(gate + ro + bj * 128); const float c255 = sc * (1.0f / 255.0f);
                    float r[8] = { v0[0] * ((float)(gv.x & 0xffu) * c255), v0[1] * ((float)((gv.x >> 8) & 0xffu) * c255), v0[2] * ((float)((gv.x >> 16) & 0xffu) * c255), v0[3] * ((float)(gv.x >> 24) * c255),
                                   v1[0] * ((float)(gv.y & 0xffu) * c255), v1[1] * ((float)((gv.y >> 8) & 0xffu) * c255), v1[2] * ((float)((gv.y >> 16) & 0xffu) * c255), v1[3] * ((float)(gv.y >> 24) * c255) };
                    if constexpr (SECOND) {
                        const pg8::u32x2 tv = *(const pg8::u32x2*)((const unsigned char*)T + ro + bj * 128); constexpr float ct = 1.0f / 64.0f;
                        const f32x2 t0 = __builtin_amdgcn_cvt_pk_f32_fp8((int)tv.x, false), t1 = __builtin_amdgcn_cvt_pk_f32_fp8((int)tv.x, true), t2 = __builtin_amdgcn_cvt_pk_f32_fp8((int)tv.y, false), t3 = __builtin_amdgcn_cvt_pk_f32_fp8((int)tv.y, true);
                        r[0] += t0.x * ct; r[1] += t0.y * ct; r[2] += t1.x * ct; r[3] += t1.y * ct; r[4] += t2.x * ct; r[5] += t2.y * ct; r[6] += t3.x * ct; r[7] += t3.y * ct; }
                    if constexpr (SECOND) {
                        int p0 = __builtin_amdgcn_cvt_pk_fp8_f32(r[0] * 16.f, r[1] * 16.f, 0, false); p0 = __builtin_amdgcn_cvt_pk_fp8_f32(r[2] * 16.f, r[3] * 16.f, p0, true);
                        int p1 = __builtin_amdgcn_cvt_pk_fp8_f32(r[4] * 16.f, r[5] * 16.f, 0, false); p1 = __builtin_amdgcn_cvt_pk_fp8_f32(r[6] * 16.f, r[7] * 16.f, p1, true);
                        pg8::u32x2 w2; w2.x = (unsigned)p0; w2.y = (unsigned)p1; *(pg8::u32x2*)((unsigned char*)out + ro + bj * 128) = w2; }
                    else { int p0 = __builtin_amdgcn_cvt_pk_fp8_f32(r[0] * 64.f, r[1] * 64.f, 0, false); p0 = __builtin_amdgcn_cvt_pk_fp8_f32(r[2] * 64.f, r[3] * 64.f, p0, true);
                        int p1 = __builtin_amdgcn_cvt_pk_fp8_f32(r[4] * 64.f, r[5] * 64.f, 0, false); p1 = __builtin_amdgcn_cvt_pk_fp8_f32(r[6] * 64.f, r[7] * 64.f, p1, true);
                        pg8::u32x2 w2; w2.x = (unsigned)p0; w2.y = (unsigned)p1; *(pg8::u32x2*)((unsigned char*)out + ro + bj * 128) = w2; } }
                asm volatile("" ::: "memory"); }
    }
};
struct EpiResid {
    static constexpr bool PERM = true;
    const bf16* base; bf16* out;
    __device__ __forceinline__ void operator()(const f32x4 (&acc)[2][2][4][2], const Unit& u, int wr, int wc, int fr, int fq) const {
        const int row0 = u.pm * 256 + wr * 64 + fr, col0 = u.pn * 256 + wc * 32 + 8 * fq;
#pragma unroll
        for (int ai = 0; ai < 2; ++ai)
#pragma unroll
            for (int m = 0; m < 4; ++m) { const int row = row0 + ai * 128 + m * 16; const size_t ro = (size_t)row * DM + col0;
#pragma unroll
                for (int bj = 0; bj < 2; ++bj) { const u32x4 bv = *(const u32x4*)(base + ro + bj * 128); const f32x4 v0 = acc[ai][bj][m][0], v1 = acc[ai][bj][m][1];
                    u32x4 w; w.x = pg8::cvt_pk_bf16(v0[0] + pg8::bf_lo(bv.x), v0[1] + pg8::bf_hi(bv.x)); w.y = pg8::cvt_pk_bf16(v0[2] + pg8::bf_lo(bv.y), v0[3] + pg8::bf_hi(bv.y));
                    w.z = pg8::cvt_pk_bf16(v1[0] + pg8::bf_lo(bv.z), v1[1] + pg8::bf_hi(bv.z)); w.w = pg8::cvt_pk_bf16(v1[2] + pg8::bf_lo(bv.w), v1[3] + pg8::bf_hi(bv.w));
                    *(u32x4*)(out + ro + bj * 128) = w; }
                asm volatile("" ::: "memory"); }
    }
};
struct EpiResidNorm {
    static constexpr bool PERM = true;
    const float* base; bf16* xb; float* ss; float sc;
    __device__ __forceinline__ void operator()(const f32x4 (&acc)[2][2][4][2], const Unit& u, int wr, int wc, int fr, int fq) const {
        const int row0 = u.pm * 256 + wr * 64 + fr, col0 = u.pn * 256 + wc * 32 + 8 * fq;
#pragma unroll
        for (int ai = 0; ai < 2; ++ai)
#pragma unroll
            for (int m = 0; m < 4; ++m) { const int row = row0 + ai * 128 + m * 16; const size_t ro = (size_t)row * DM + col0; float q = 0.f;
#pragma unroll
                for (int bj = 0; bj < 2; ++bj) { const f32x4 b0 = *(const f32x4*)(base + ro + bj * 128), b1 = *(const f32x4*)(base + ro + bj * 128 + 4);
                    const f32x4 y0 = acc[ai][bj][m][0] * sc + b0, y1 = acc[ai][bj][m][1] * sc + b1;
                    u32x4 w; w.x = pg8::cvt_pk_bf16(y0[0], y0[1]); w.y = pg8::cvt_pk_bf16(y0[2], y0[3]); w.z = pg8::cvt_pk_bf16(y1[0], y1[1]); w.w = pg8::cvt_pk_bf16(y1[2], y1[3]);
                    *(u32x4*)(xb + ro + bj * 128) = w;
                    q += ((y0[0] * y0[0] + y0[1] * y0[1]) + (y0[2] * y0[2] + y0[3] * y0[3])) + ((y1[0] * y1[0] + y1[1] * y1[1]) + (y1[2] * y1[2] + y1[3] * y1[3])); }
                q += __shfl_xor(q, 16); q += __shfl_xor(q, 32);
                if (fq == 0) ss[(size_t)(4 * u.pn + wc) * M + row] = q;
                asm volatile("" ::: "memory"); }
    }
};
constexpr int RSTD_LDS_OFF = 135168;
struct EpiUp {
    static constexpr bool PERM = true;
    bf16* H; const float* ss; LAS float* rl; mutable int cpm;
    __device__ __forceinline__ void operator()(const f32x4 (&acc)[2][2][4][2], const Unit& u, int wr, int wc, int fr, int fq) const {
        if (u.pm != cpm) {
            __syncthreads();
            int t_ = threadIdx.x; asm volatile("" : "+v"(t_));
            const int prow = t_ >> 1, half = t_ & 1; const float* sp = ss + (size_t)(32 * half) * M + u.pm * 256 + prow; float q = 0.f;
#pragma unroll 8
            for (int i = 0; i < 32; ++i) q += sp[(size_t)i * M];
            q += __shfl_xor(q, 1);
            if (half == 0) rl[prow] = 1.0f / sqrtf(q * (1.f / DM) + EPS);
            __syncthreads();
            cpm = u.pm;
        }
        const int row0 = u.pm * 256 + wr * 64 + fr, col0 = u.pn * 256 + wc * 32 + 8 * fq;
#pragma unroll
        for (int ai = 0; ai < 2; ++ai)
#pragma unroll
            for (int m = 0; m < 4; ++m) { const int row = row0 + ai * 128 + m * 16; bf16* rowp = H + (size_t)row * DFF + col0; const float rs = rl[row & 255];
#pragma unroll
                for (int bj = 0; bj < 2; ++bj) { f32x4 v0 = acc[ai][bj][m][0] * rs, v1 = acc[ai][bj][m][1] * rs;
#pragma unroll
                    for (int j = 0; j < 4; ++j) { const float a = fmaxf(v0[j], 0.f), b = fmaxf(v1[j], 0.f); v0[j] = a * a; v1[j] = b * b; }
                    u32x4 w; w.x = pg8::cvt_pk_bf16(v0[0], v0[1]); w.y = pg8::cvt_pk_bf16(v0[2], v0[3]); w.z = pg8::cvt_pk_bf16(v1[0], v1[1]); w.w = pg8::cvt_pk_bf16(v1[2], v1[3]);
                    *(u32x4*)(rowp + bj * 128) = w; } }
    }
};

__device__ __forceinline__ float relu_bits(float x) { const int i = __builtin_bit_cast(int, x); return __builtin_bit_cast(float, i > 0 ? i : 0); }
constexpr int SC_PAD = 320;
constexpr size_t SC_PERB = (size_t)4096 * (NCHUNK * (NCHUNK + 1) / 2) + (size_t)64 * SC_PAD * NCHUNK;
__device__ __forceinline__ size_t score_off(int b, int c) { return (size_t)b * SC_PERB + (size_t)4096 * ((size_t)c * (c + 1) / 2) + (size_t)64 * SC_PAD * c; }
__device__ __forceinline__ void p2_scores(Frame& F) {
    const int gw = F.vcu * NWAVES + F.wave, NGW = F.G * NWAVES, lane = F.lane, r = lane & 31, hi = lane >> 5;
    if (gw < BATCH * NH) {
        const int b = gw / NH, h = gw % NH; const float* fl = (const float*)(F.ws + WS_FL) + (size_t)b * SEQ * 16 + h; float* cum = (float*)(F.ws + WS_CUM) + (size_t)(b * NH + h) * SEQ;
        float vals[128];
#pragma unroll
        for (int i = 0; i < 128; ++i) vals[i] = fl[(size_t)(128 * lane + i) * 16];
        float run = 0.f;
#pragma unroll
        for (int i = 0; i < 128; ++i) { run += vals[i]; vals[i] = run; }
        float incl = run;
#pragma unroll
        for (int o = 1; o < 64; o <<= 1) { const float t = __shfl_up(incl, o); if (lane >= o) incl += t; }
        const float off = incl - run;
#pragma unroll
        for (int i = 0; i < 128; i += 4) *(f32x4*)(cum + 128 * lane + i) = (f32x4){vals[i] + off, vals[i + 1] + off, vals[i + 2] + off, vals[i + 3] + off};
    }
    {
        const bf16* QBp = (const bf16*)(F.ws + WS_E) + (size_t)M * DA; const bf16* KBp = (const bf16*)(F.ws + WS_E) + 4 * (size_t)M * DA;
        float* nrm = (float*)(F.ws + WS_NORM);
        for (int it = gw; it < 2 * BATCH * NH * 128; it += NGW) {
            const int which = it & 1, tile = (it >> 1) & 127, bh = it >> 8, b = bh >> 4, h = bh & 15;
            const bf16* src = (which ? QBp : KBp) + ((size_t)b * SEQ + tile * 64 + lane) * DA + h * HD;
            float ss = 0.f;
#pragma unroll
            for (int i = 0; i < 16; ++i) { const u32x4 w = *(const u32x4*)(src + 8 * i);
                const float a0 = pg8::bf_lo(w.x), a1 = pg8::bf_hi(w.x), a2 = pg8::bf_lo(w.y), a3 = pg8::bf_hi(w.y), a4 = pg8::bf_lo(w.z), a5 = pg8::bf_hi(w.z), a6 = pg8::bf_lo(w.w), a7 = pg8::bf_hi(w.w);
                ss += (a0 * a0 + a1 * a1) + (a2 * a2 + a3 * a3) + (a4 * a4 + a5 * a5) + (a6 * a6 + a7 * a7); }
#pragma unroll
            for (int o = 1; o < 64; o <<= 1) ss = fmaxf(ss, __shfl_xor(ss, o));
            if (lane == 0) nrm[(size_t)(which * BATCH * NH + bh) * 128 + tile] = sqrtf(ss) * 1.001f;
        }
    }
}
__device__ __forceinline__ unsigned sortable(float f) { const unsigned u = __builtin_bit_cast(unsigned, f); return u ^ ((u >> 31) ? 0xFFFFFFFFu : 0x80000000u); }
__device__ __forceinline__ void select_regs(Frame& F, int row, unsigned (&v)[128]);
__device__ __forceinline__ void p2_index_select(Frame& F) {
    const int lane = F.lane, r = lane & 31, hi = lane >> 5, wave = F.wave;
    const bf16* IQ = (const bf16*)(F.ws + WS_IQ); const bf16* IK = (const bf16*)(F.ws + WS_IK); const float* IW = (const float*)(F.ws + WS_IW); float* SC = (float*)(F.ws + WS_SCORE);
    float* dummy = (float*)(F.ws + WS_MISC) + (size_t)(F.vcu * NWAVES + wave) * 64;
    LAS unsigned char* tl = F.lds + RING_OFF;
    for (int wu = blockIdx.x; wu < 2048; wu += F.G) {
        const int w = wu & 255, i8 = wu >> 8, p = w & 63, b = (w >> 6) & 1, c = (i8 & 1) ? 127 - p : p, qg = 4 * (w >> 7) + (i8 >> 1);
        const int limit = 64 * (c + 1), ntile = (limit + 127) >> 7;
        const size_t row = (size_t)b * SEQ + 64 * c + 8 * qg + wave;
        f32x4 wv[4];
        LAS unsigned char* asl = tl + 6 * 16384 + wave * 4096 + lane * 16;
        { f16x8 a_[4];
#pragma unroll
          for (int st = 0; st < 4; ++st) a_[st] = *(const f16x8*)(IQ + row * 2048 + 512 * st + lane * 8);
#pragma unroll
          for (int st = 0; st < 4; ++st) *(LAS f16x8*)(asl + st * 1024) = a_[st]; }
#pragma unroll
        for (int g4 = 0; g4 < 4; ++g4) wv[g4] = *(const f32x4*)(IW + row * 32 + 8 * g4 + 4 * hi);
        const char* ikb = (const char*)(IK + ((size_t)b * SEQ / 32) * 2048);
        unsigned v[128];
#pragma unroll
        for (int i = 0; i < 128; ++i) v[i] = 0u;
#define IDX_STAGE(t_, b_) do { const int tt_ = (t_) < ntile ? (t_) : ntile - 1; _Pragma("unroll") for (int i_ = 0; i_ < 2; ++i_) \
            __builtin_amdgcn_global_load_lds((const unsigned*)(ikb + (size_t)tt_ * 16384 + i_ * 8192 + wave * 1024 + lane * 16), (LAS unsigned*)(tl + (b_) * 16384 + i_ * 8192 + wave * 1024), 16, 0, 0); } while (0)
        IDX_STAGE(0, 0); IDX_STAGE(1, 1); IDX_STAGE(2, 2); IDX_STAGE(3, 3); IDX_STAGE(4, 4);
        asm volatile("s_waitcnt vmcnt(8)" ::: "memory"); asm volatile("s_waitcnt lgkmcnt(0)" ::: "memory"); __builtin_amdgcn_s_barrier(); asm volatile("" ::: "memory");
        for (int g6 = 0; 6 * g6 < ntile; ++g6) {
#pragma unroll
            for (int u = 0; u < 6; ++u) {
                const int t = 6 * g6 + u;
                if (t < ntile) {
                    IDX_STAGE(t + 5, (u + 5) % 6);
                    const LAS unsigned char* tb_ = tl + u * 16384 + lane * 16;
                    unsigned sk[2];
#pragma unroll
                    for (int h2 = 0; h2 < 2; ++h2) {
                        float a01[2];
#pragma unroll
                        for (int e = 0; e < 2; ++e) {
                            f32x16 acc = {};
#pragma unroll
                            for (int st = 0; st < 4; ++st) acc = __builtin_amdgcn_mfma_f32_32x32x16_f16(*(const LAS f16x8*)(asl + st * 1024), *(const LAS f16x8*)(tb_ + (2 * h2 + e) * 4096 + st * 1024), acc, 0, 0, 0);
                            f32x2 s0 = {0.f, 0.f};
#pragma unroll
                            for (int q = 0; q < 16; q += 2) { f32x2 w2; w2.x = wv[q >> 2][q & 3]; w2.y = wv[(q + 1) >> 2][(q + 1) & 3]; f32x2 r0; r0.x = relu_bits(acc[q]); r0.y = relu_bits(acc[q + 1]); s0 = w2 * r0 + s0; }
                            float a = s0.x + s0.y; a += __shfl_xor(a, 32); a01[e] = a;
                        }
                        const float sv = hi ? a01[1] : a01[0]; const int key = 128 * t + 64 * h2 + lane;
                        sk[h2] = (key < limit) ? sortable(sv) : 0u;
                    }
                    switch (g6) {
#define IDX_PARK(k_) case k_: if (12 * k_ + 2 * u + 1 < 128) { v[(12 * k_ + 2 * u) & 127] = sk[0]; v[(12 * k_ + 2 * u + 1) & 127] = sk[1]; } break;
                        IDX_PARK(0) IDX_PARK(1) IDX_PARK(2) IDX_PARK(3) IDX_PARK(4) IDX_PARK(5) IDX_PARK(6) IDX_PARK(7) IDX_PARK(8) IDX_PARK(9) IDX_PARK(10)
#undef IDX_PARK
                        default: break;
                    }
                    asm volatile("s_waitcnt vmcnt(8)" ::: "memory"); asm volatile("s_waitcnt lgkmcnt(0)" ::: "memory"); __builtin_amdgcn_s_barrier(); asm volatile("" ::: "memory");
                }
                __builtin_amdgcn_sched_barrier(0);
            }
        }
#undef IDX_STAGE
        asm volatile("s_waitcnt vmcnt(0)" ::: "memory"); __builtin_amdgcn_s_barrier(); asm volatile("" ::: "memory");
        select_regs(F, (int)row, v);
    }
}

__device__ __forceinline__ void select_regs(Frame& F, int row, unsigned (&v)[128]) {
    const int lane = F.lane;
    unsigned long long* MK = (unsigned long long*)(F.ws + WS_MASK);
        const int t = row % SEQ, c = t / 64, nsl = c + 1;
        unsigned long long* mrow = MK + (size_t)row * 128;
        if (nsl <= 4) { int l_ = lane; asm volatile("" : "+v"(l_)); mrow[l_] = (l_ < nsl) ? ~0ull : 0ull; mrow[l_ + 64] = 0ull; return; }
        unsigned q0 = 0u, q1 = 0u, q2 = 0u, q3 = 0u;
#pragma unroll
        for (int g = 0; g < 8; ++g) if (g * 16 < nsl) {
#pragma unroll
            for (int j = 0; j < 16; j += 4) { q0 = q0 > v[g * 16 + j] ? q0 : v[g * 16 + j]; q1 = q1 > v[g * 16 + j + 1] ? q1 : v[g * 16 + j + 1];
                q2 = q2 > v[g * 16 + j + 2] ? q2 : v[g * 16 + j + 2]; q3 = q3 > v[g * 16 + j + 3] ? q3 : v[g * 16 + j + 3]; } }
        unsigned vmax = q0 > q1 ? q0 : q1; { const unsigned t2 = q2 > q3 ? q2 : q3; vmax = vmax > t2 ? vmax : t2; }
        unsigned lmin = q0 < q1 ? q0 : q1; { const unsigned t2 = q2 < q3 ? q2 : q3; lmin = lmin < t2 ? lmin : t2; }
#pragma unroll
        for (int o = 1; o < 64; o <<= 1) { const unsigned ot = __shfl_xor(vmax, o); vmax = vmax > ot ? vmax : ot; const unsigned ol = __shfl_xor(lmin, o); lmin = lmin < ol ? lmin : ol; }
        const unsigned dx = vmax ^ lmin;
        const int topbit = dx ? 31 - __builtin_clz(dx) : -1;
        unsigned prefix = (topbit >= 31) ? 0u : (topbit < 0 ? vmax : (vmax & ~((2u << topbit) - 1u))); bool exact = false;
        for (int bit = topbit; bit >= 0; --bit) {
            const unsigned cand = prefix | (1u << bit); unsigned cnt = 0u;
#pragma unroll
            for (int g = 0; g < 8; ++g) if (g * 16 < nsl) { unsigned cd = cand; asm volatile("" : "+v"(cd));
#pragma unroll
                for (int j = 0; j < 16; ++j) cnt += (v[g * 16 + j] >= cd) ? 1u : 0u; }
#pragma unroll
            for (int o = 1; o < 64; o <<= 1) cnt += __shfl_xor(cnt, o);
            if (cnt >= (unsigned)TOPK) prefix = cand;
            if (cnt == (unsigned)TOPK) { exact = true; break; }
        }
        if (exact) {
#pragma unroll
            for (int sl = 0; sl < 128; ++sl) { const unsigned long long word = (sl < nsl) ? __ballot(v[sl] >= prefix) : 0ull;
                mrow[sl] = word;
                if ((sl & 7) == 7) __builtin_amdgcn_sched_barrier(0); }
            return;
        }
        unsigned cgt = 0u;
#pragma unroll
        for (int g = 0; g < 8; ++g) if (g * 16 < nsl) {
#pragma unroll
            for (int j = 0; j < 16; ++j) cgt += (v[g * 16 + j] > prefix) ? 1u : 0u; }
#pragma unroll
        for (int o = 1; o < 64; o <<= 1) cgt += __shfl_xor(cgt, o);
        unsigned need = (unsigned)TOPK - cgt, seen = 0u;
#pragma unroll
        for (int g = 0; g < 8; ++g) {
#pragma unroll
            for (int j = 0; j < 16; ++j) { const int sl = g * 16 + j;
                unsigned long long word = 0ull;
                if (sl < nsl) {
                    const bool gt = v[sl] > prefix, eq = v[sl] == prefix;
                    const unsigned long long eqm = __ballot(eq);
                    const unsigned before = seen + (unsigned)__popcll(eqm & ((1ull << lane) - 1ull));
                    word = __ballot(gt || (eq && before < need));
                    seen += (unsigned)__popcll(eqm);
                }
                if (lane == 0) mrow[sl] = word; }
        }
}

__device__ __forceinline__ int t5_bucket(int rel) {
    const int n = rel < 0 ? -rel : rel; int bkt;
    if (n < 8) bkt = n; else bkt = 8 + (n >= 15) + (n >= 27) + (n >= 50) + (n >= 91) + (n >= 166) + (n >= 305) + (n >= 559);
    return (rel > 0 ? 16 : 0) + bkt;
}

namespace att {
constexpr int NW = 8, QBLK = 32, KVBLK = 64, QB = NW * QBLK, D = 128, LD = 2048;
constexpr int SHM_V = KVBLK * D * 2, SHM_K = KVBLK * D * 2;
constexpr int OFF_WS = 2 * SHM_V + 2 * SHM_K, OFF_TB = OFF_WS + NW * 64 * 4, TB_N = 1088, OFF_DK = OFF_TB, LDS_NEED = OFF_DK + 132 * 64 * 4;
constexpr float SCALE = 0.08838834764831845f, INV_SCALE = 11.313708498984761f, THR = 8.f;
typedef short bf16x8 __attribute__((ext_vector_type(8)));
typedef short s16x4 __attribute__((ext_vector_type(4)));
typedef float f32x16 __attribute__((ext_vector_type(16)));
typedef unsigned u32x4 __attribute__((ext_vector_type(4)));
#define KSWZ(row, colB) ((row) * 256 + ((colB) ^ (((row) & 7) << 4)))
#define K8SWZ(row, ch) ((row) * 128 + ((((ch) ^ (((row) >> 1) & 7))) << 4))
#define SBAR() __builtin_amdgcn_sched_barrier(0)
__device__ __forceinline__ int v_st(int k, int c) { const int kk = (k & ~0xC) | ((k & 4) << 1) | ((k & 8) >> 1); return ((kk >> 3) * 4 + (c >> 5)) * 512 + ((kk & 7) * 32 + (c & 31)) * 2; }
__device__ __forceinline__ int v_rd_base(int lane) { return ((lane & 3) << 3) | (((lane >> 2) & 3) << 6) | (((lane >> 4) & 1) << 5) | (((lane >> 5) & 1) << 8); }
constexpr int v_rd_off(int d0, int ks, int half) { return d0 * 512 + ks * 4096 + half * 2048; }
__device__ __forceinline__ int crow(int r, int hi) { return (r & 3) + 8 * (r >> 2) + 4 * hi; }
__device__ __forceinline__ unsigned cvtpk(float lo, float hi) { return pg8::cvt_pk_bf16(lo, hi); }
__device__ __forceinline__ void mask_tile(f32x16& p0, f32x16& p1, int lr, int sdq) {
    const float NEG = -__builtin_inff();
#pragma unroll
    for (int r = 0; r < 16; ++r) { const int c = (r & 3) + 8 * (r >> 2); if (lr < c - sdq) p0[r] = NEG; if (lr < c + 32 - sdq) p1[r] = NEG; }
}
template <bool F8P = false>
__device__ __forceinline__ void partialSM(f32x16& p0, f32x16& p1, float& m_reg, float& mn, float& alpha) {
    float pmax = p0[0];
#pragma unroll
    for (int r = 1; r < 16; ++r) pmax = fmaxf(pmax, p0[r]);
#pragma unroll
    for (int r = 0; r < 16; ++r) pmax = fmaxf(pmax, p1[r]);
    { auto rr = __builtin_amdgcn_permlane32_swap(__float_as_uint(pmax), __float_as_uint(pmax), false, false); pmax = fmaxf(__uint_as_float(rr[0]), __uint_as_float(rr[1])); }
    constexpr float C2 = 1.4426950408889634f * SCALE;
    if (__builtin_expect(__all((pmax - m_reg) * SCALE <= (F8P ? 1.5f : THR)), 1)) { mn = m_reg; alpha = 1.f; }
    else { mn = fmaxf(m_reg, pmax); alpha = __builtin_amdgcn_exp2f((m_reg - mn) * C2); m_reg = mn; }
    const float mnL = -mn * C2 + (F8P ? 6.f : 0.f);
#pragma unroll
    for (int r = 0; r < 16; ++r) p0[r] = fmaf(p0[r], C2, mnL);
#pragma unroll
    for (int r = 0; r < 16; ++r) p1[r] = fmaf(p1[r], C2, mnL);
#pragma unroll
    for (int r = 0; r < 16; ++r) p0[r] = __builtin_amdgcn_exp2f(p0[r]);
}
__device__ __forceinline__ void finishSM(f32x16& p0, f32x16& p1, float alpha, float& l_reg, bf16x8& pa0, bf16x8& pa1, bf16x8& pa2, bf16x8& pa3) {
#pragma unroll
    for (int r = 0; r < 16; ++r) p1[r] = __builtin_amdgcn_exp2f(p1[r]);
    float ps = 0;
#pragma unroll
    for (int r = 0; r < 16; ++r) ps += p0[r];
#pragma unroll
    for (int r = 0; r < 16; ++r) ps += p1[r];
    { auto rr = __builtin_amdgcn_permlane32_swap(__float_as_uint(ps), __float_as_uint(ps), false, false); ps = __uint_as_float(rr[0]) + __uint_as_float(rr[1]); }
    l_reg = l_reg * alpha + ps;
#define PK4(P, B_, OUT) do { unsigned a0 = cvtpk(P[B_+0], P[B_+1]), a1 = cvtpk(P[B_+2], P[B_+3]); unsigned b0 = cvtpk(P[B_+4], P[B_+5]), b1 = cvtpk(P[B_+6], P[B_+7]); \
        auto r0 = __builtin_amdgcn_permlane32_swap(a0, b0, false, false); auto r1 = __builtin_amdgcn_permlane32_swap(a1, b1, false, false); \
        u32x4 w = {r0[0], r1[0], r0[1], r1[1]}; OUT = *reinterpret_cast<bf16x8*>(&w); } while (0)
    PK4(p0, 0, pa0); PK4(p0, 8, pa1); PK4(p1, 0, pa2); PK4(p1, 8, pa3);
#undef PK4
}
template <int KB>
__device__ __forceinline__ void qkt8(f32x16& p0, f32x16& p1, const char* K_lds, int r32, int hi, const bf16x8* qr) {
    typedef int i32x4_ __attribute__((ext_vector_type(4))); typedef int i32x8_ __attribute__((ext_vector_type(8)));
    const char* kt = K_lds + KB * SHM_K;
#pragma unroll
    for (int j = 0; j < 2; ++j) {
        const i32x8_ qv = __builtin_shufflevector(__builtin_bit_cast(i32x4_, qr[2 * j]), __builtin_bit_cast(i32x4_, qr[2 * j + 1]), 0, 1, 2, 3, 4, 5, 6, 7);
        const int c0 = 4 * j + 2 * hi;
        const i32x8_ k0v = __builtin_shufflevector(*(const i32x4_*)(kt + K8SWZ(r32, c0)), *(const i32x4_*)(kt + K8SWZ(r32, c0 + 1)), 0, 1, 2, 3, 4, 5, 6, 7);
        const i32x8_ k1v = __builtin_shufflevector(*(const i32x4_*)(kt + K8SWZ(32 + r32, c0)), *(const i32x4_*)(kt + K8SWZ(32 + r32, c0 + 1)), 0, 1, 2, 3, 4, 5, 6, 7);
        p0 = __builtin_amdgcn_mfma_scale_f32_32x32x64_f8f6f4(k0v, qv, p0, 0, 0, 0, 0x7f7f7f7f, 0, 0x7f7f7f7f);
        p1 = __builtin_amdgcn_mfma_scale_f32_32x32x64_f8f6f4(k1v, qv, p1, 0, 0, 0, 0x7f7f7f7f, 0, 0x7f7f7f7f);
    }
}
template <int KB>
__device__ __forceinline__ void qkt(f32x16& p0, f32x16& p1, const char* K_lds, int r32, int hi, const bf16x8* qr) {
    const char* kb[4];
#pragma unroll
    for (int dd = 0; dd < 4; ++dd) kb[dd] = K_lds + KB * SHM_K + KSWZ(r32, (dd * 16 + hi * 8) * 2);
#pragma unroll
    for (int d0 = 0; d0 < 8; ++d0) { const char* a = kb[d0 & 3] + (d0 >> 2) * 128;
        bf16x8 b0 = *reinterpret_cast<const bf16x8*>(a);
        bf16x8 b1 = *reinterpret_cast<const bf16x8*>(a + 32 * 256);
        p0 = __builtin_amdgcn_mfma_f32_32x32x16_bf16(b0, qr[d0], p0, 0, 0, 0);
        p1 = __builtin_amdgcn_mfma_f32_32x32x16_bf16(b1, qr[d0], p1, 0, 0, 0); }
}
template <int VB>
__device__ __forceinline__ void pv_tile(f32x16* o, int vb0, bf16x8 pa0, bf16x8 pa1, bf16x8 pa2, bf16x8 pa3) {
#define TRRD(dst, off) asm volatile("ds_read_b64_tr_b16 %0, %1 offset:%2" : "=&v"(dst) : "v"(vb0), "i"(off) : "memory")
#define PV_D0(d0) do { s16x4 l0, l1, l2, l3, h0, h1, h2, h3; constexpr int b_ = VB * SHM_V + v_rd_off(d0, 0, 0); \
        TRRD(l0, b_); TRRD(h0, b_ + 2048); TRRD(l1, b_ + 4096); TRRD(h1, b_ + 6144); TRRD(l2, b_ + 8192); TRRD(h2, b_ + 10240); TRRD(l3, b_ + 12288); TRRD(h3, b_ + 14336); \
        asm volatile("s_waitcnt lgkmcnt(0)" ::: "memory"); SBAR(); \
        o[d0] = __builtin_amdgcn_mfma_f32_32x32x16_bf16(pa0, (bf16x8){l0[0], l0[1], l0[2], l0[3], h0[0], h0[1], h0[2], h0[3]}, o[d0], 0, 0, 0); \
        o[d0] = __builtin_amdgcn_mfma_f32_32x32x16_bf16(pa1, (bf16x8){l1[0], l1[1], l1[2], l1[3], h1[0], h1[1], h1[2], h1[3]}, o[d0], 0, 0, 0); \
        o[d0] = __builtin_amdgcn_mfma_f32_32x32x16_bf16(pa2, (bf16x8){l2[0], l2[1], l2[2], l2[3], h2[0], h2[1], h2[2], h2[3]}, o[d0], 0, 0, 0); \
        o[d0] = __builtin_amdgcn_mfma_f32_32x32x16_bf16(pa3, (bf16x8){l3[0], l3[1], l3[2], l3[3], h3[0], h3[1], h3[2], h3[3]}, o[d0], 0, 0, 0); } while (0)
    PV_D0(0); PV_D0(1); PV_D0(2); PV_D0(3);
#undef PV_D0
#undef TRRD
}
#define V8SWZ(row, ch) ((row) * 128 + ((((ch) ^ ((row) & 7))) << 4))
__device__ __forceinline__ void finishSM8(f32x16& p0, f32x16& p1, float alpha, float& l_reg, bf16x8& pa0, bf16x8& pa1) {
#pragma unroll
    for (int r = 0; r < 16; ++r) p1[r] = __builtin_amdgcn_exp2f(p1[r]);
    float ps = 0;
#pragma unroll
    for (int r = 0; r < 16; ++r) ps += p0[r];
#pragma unroll
    for (int r = 0; r < 16; ++r) ps += p1[r];
    { auto rr = __builtin_amdgcn_permlane32_swap(__float_as_uint(ps), __float_as_uint(ps), false, false); ps = __uint_as_float(rr[0]) + __uint_as_float(rr[1]); }
    l_reg = l_reg * alpha + ps;
    unsigned w[8];
#pragma unroll
    for (int g = 0; g < 4; ++g) {
        int x = __builtin_amdgcn_cvt_pk_fp8_f32(p0[4 * g], p0[4 * g + 1], 0, false); x = __builtin_amdgcn_cvt_pk_fp8_f32(p0[4 * g + 2], p0[4 * g + 3], x, true);
        int y = __builtin_amdgcn_cvt_pk_fp8_f32(p1[4 * g], p1[4 * g + 1], 0, false); y = __builtin_amdgcn_cvt_pk_fp8_f32(p1[4 * g + 2], p1[4 * g + 3], y, true);
        auto rr = __builtin_amdgcn_permlane32_swap((unsigned)x, (unsigned)y, false, false);
        w[2 * g] = rr[0]; w[2 * g + 1] = rr[1]; }
    u32x4 a = {w[0], w[1], w[2], w[3]}, b = {w[4], w[5], w[6], w[7]};
    pa0 = *reinterpret_cast<bf16x8*>(&a); pa1 = *reinterpret_cast<bf16x8*>(&b);
}
template <int VB>
__device__ __forceinline__ void pv_tile8(f32x16* o, int vbase, int vb8, bf16x8 pa0, bf16x8 pa1) {
    typedef int i32x4_ __attribute__((ext_vector_type(4))); typedef int i32x8_ __attribute__((ext_vector_type(8))); typedef int i32x2_ __attribute__((ext_vector_type(2)));
    const i32x8_ pv = __builtin_shufflevector(__builtin_bit_cast(i32x4_, pa0), __builtin_bit_cast(i32x4_, pa1), 0, 1, 2, 3, 4, 5, 6, 7);
#pragma unroll
    for (int db = 0; db < 4; ++db) {
        const int ad = vbase + (vb8 ^ (db << 5));
        i32x2_ t0, t1, t2, t3;
        asm volatile("ds_read_b64_tr_b8 %0, %1 offset:%2" : "=&v"(t0) : "v"(ad), "i"(VB * SHM_V) : "memory");
        asm volatile("ds_read_b64_tr_b8 %0, %1 offset:%2" : "=&v"(t1) : "v"(ad), "i"(VB * SHM_V + 1024) : "memory");
        asm volatile("ds_read_b64_tr_b8 %0, %1 offset:%2" : "=&v"(t2) : "v"(ad), "i"(VB * SHM_V + 2048) : "memory");
        asm volatile("ds_read_b64_tr_b8 %0, %1 offset:%2" : "=&v"(t3) : "v"(ad), "i"(VB * SHM_V + 3072) : "memory");
        asm volatile("s_waitcnt lgkmcnt(0)" ::: "memory"); SBAR();
        const i32x8_ vv = {t0[0], t0[1], t1[0], t1[1], t2[0], t2[1], t3[0], t3[1]};
        o[db] = __builtin_amdgcn_mfma_scale_f32_32x32x64_f8f6f4(pv, vv, o[db], 0, 0, 0, 0x7f7f7f7f, 0, 0x7f7f7f7f);
    }
}
struct BlockRef { const bf16* Q; const bf16* K; const bf16* V; bf16* O; int P0, jlo; const unsigned long long* MK; const float* cum; };
struct Seam { bf16x8 qr[8]; bf16x8 st_v0, st_v1, st_k0, st_k1; };
#define AROW(p, k0, rr) ((p) + (size_t)((k0) + (rr)) * LD + sc)
#define VMW() asm volatile("s_waitcnt vmcnt(0)" ::: "memory")
#define VMWN(n) asm volatile("s_waitcnt vmcnt(%0)" :: "i"(n) : "memory")
#define SLOAD_H(Kp, Vp, k0) do { \
        if constexpr (MODE == 0) { S.st_v0 = *(const bf16x8*)((const char*)(Vp) + (size_t)((k0) + (tid >> 3)) * LD + (tid & 7) * 16); S.st_k0 = *(const bf16x8*)((const char*)(Kp) + (size_t)((k0) + (tid >> 3)) * LD + (tid & 7) * 16); } \
        else { S.st_v0 = *(const bf16x8*)AROW(Vp, k0, sr); S.st_v1 = *(const bf16x8*)AROW(Vp, k0, 32 + sr); S.st_k0 = *(const bf16x8*)AROW(Kp, k0, sr); S.st_k1 = *(const bf16x8*)AROW(Kp, k0, 32 + sr); } } while (0)
#define SWRITE_HK(bf) do { if constexpr (MODE == 0) { *(bf16x8*)(K_lds + (bf) * SHM_K + K8SWZ(tid >> 3, tid & 7)) = S.st_k0; } \
        else { *(bf16x8*)(K_lds + (bf) * SHM_K + kws) = S.st_k0; *(bf16x8*)(K_lds + (bf) * SHM_K + kws + 32 * 256) = S.st_k1; } } while (0)
#define QLOAD(Qp) do { if constexpr (MODE == 0) { const char* q8_ = (const char*)(Qp) + (size_t)(wid * QBLK + r32) * LD + 32 * hi; \
            S.qr[0] = *(const bf16x8*)(q8_); S.qr[1] = *(const bf16x8*)(q8_ + 16); S.qr[2] = *(const bf16x8*)(q8_ + 64); S.qr[3] = *(const bf16x8*)(q8_ + 80); } \
        else { _Pragma("unroll") for (int d0 = 0; d0 < 8; ++d0) S.qr[d0] = *(const bf16x8*)((Qp) + (size_t)(wid * QBLK + r32) * LD + d0 * 16 + hi * 8); } } while (0)
#define SWRITE_HV(bf) do { if constexpr (MODE == 0) { *(bf16x8*)(V_lds + (bf) * SHM_V + V8SWZ(tid >> 3, tid & 7)) = S.st_v0; } \
        else { *(bf16x8*)(V_lds + (bf) * SHM_V + vst0) = S.st_v0; *(bf16x8*)(V_lds + (bf) * SHM_V + vst1) = S.st_v1; } } while (0)
template <int MODE>
__device__ __forceinline__ void attn_prime(const BlockRef& cur, char* lds, Seam& S) {
    int tid_ = threadIdx.x; asm volatile("" : "+v"(tid_)); const int tid = tid_, wid = __builtin_amdgcn_readfirstlane(tid >> 6), lane = tid & 63, r32 = lane & 31, hi = lane >> 5;
    const int sr = tid >> 4, sc = (tid & 15) * 8, kws = KSWZ(sr, sc * 2); char* K_lds = lds + 2 * SHM_V;
    const int kb0 = cur.jlo * KVBLK;
    QLOAD(cur.Q);
    SLOAD_H(cur.K, cur.V, kb0); VMW(); SWRITE_HK(0);
    __syncthreads();
}
template <int MODE>
__device__ __forceinline__ void attn_block(const BlockRef& cur, const BlockRef& nxt, const float* bias_h, char* lds, Seam& S) {
    int tid_ = threadIdx.x; asm volatile("" : "+v"(tid_)); const int tid = tid_, wid = __builtin_amdgcn_readfirstlane(tid >> 6), lane = tid & 63, r32 = lane & 31, hi = lane >> 5;
    const int j_lo = cur.jlo, j_hi = cur.P0 / KVBLK + 4, NT = j_hi - j_lo;
    const int kbn = nxt.jlo * KVBLK;
    const int qlo = cur.P0 + wid * QBLK; int lr = r32 - 4 * hi; asm volatile("" : "+v"(lr));
    char* V_lds = lds; char* K_lds = lds + 2 * SHM_V;
    float* ws = (float*)(lds + OFF_WS) + wid * 64; float* li_l = ws, * al_l = ws + 32;
    float* tb = (float*)(lds + OFF_TB); float* dkb = (float*)(lds + OFF_DK);
    float m_reg = -1e30f, l_reg = 0; f32x16 o[4] = {};
    const int sr = tid >> 4, sc = (tid & 15) * 8, vst0 = v_st(sr, sc), vst1 = v_st(32 + sr, sc), kws = KSWZ(sr, sc * 2);
    const int vb0 = (int)(uintptr_t)V_lds + v_rd_base(lane);
    const int vb8 = (32 * hi + ((lane & 15) >> 1)) * 128 + (((((lane >> 4) & 1)) ^ ((lane & 15) >> 1)) << 4) + 8 * (lane & 1);
#define FIN(P0_, P1_, al_) do { if constexpr (MODE == 0) finishSM8(P0_, P1_, al_, l_reg, pa0, pa1); else finishSM(P0_, P1_, al_, l_reg, pa0, pa1, pa2, pa3); } while (0)
#define PVT(VB_) do { if constexpr (MODE == 0) pv_tile8<VB_>(o, (int)(uintptr_t)V_lds, vb8, pa0, pa1); else pv_tile<VB_>(o, vb0, pa0, pa1, pa2, pa3); } while (0)
#define PSM(P0_, P1_, mn_, al_) partialSM<MODE == 0>(P0_, P1_, m_reg, mn_, al_)
    const bf16* Kh = cur.K; const bf16* Vh = cur.V;
    const float NEG = -__builtin_inff();
    const unsigned long long* mrow = nullptr; unsigned long long mw_cur = 0ull, mw_nxt = 0ull; float c15 = 0.f;
    float cref = 0.f;
    if constexpr (MODE == 0) {
        mrow = cur.MK + (size_t)(wid * QBLK + r32) * 128;
        for (int i = tid; i < TB_N; i += NW * 64) tb[i] = bias_h[t5_bucket(i - 1023) * NH] * INV_SCALE;
        c15 = bias_h[15 * NH] * INV_SCALE;
        mw_cur = mrow[j_lo];
    } else {
        cref = cur.cum[cur.P0];
        for (int i = tid; i < NT * KVBLK; i += NW * 64) dkb[i] = -(cur.cum[j_lo * KVBLK + i] - cref) * INV_SCALE;
    }
#define RESC(a) do { if (__any((a) < 1.f)) { if (hi == 0) al_l[r32] = (a); asm volatile("s_waitcnt lgkmcnt(0)" ::: "memory"); \
                     for (int d_ = 0; d_ < 4; ++d_) for (int r = 0; r < 16; ++r) o[d_][r] *= al_l[crow(r, hi)]; } } while (0)
#define KBASE(t) ((j_lo + (t)) * KVBLK)
#define PINIT(P0_, P1_, t, DB) do { \
        if constexpr (MODE == 0) { const unsigned lo_ = (unsigned)mw_cur >> (4 * hi), hi_ = (unsigned)(mw_cur >> 32) >> (4 * hi); const int kb_ = KBASE(t); \
            if (kb_ + 63 - qlo <= -559) { _Pragma("unroll") for (int r = 0; r < 16; ++r) { const int c = (r & 3) + 8 * (r >> 2); P0_[r] = ((lo_ >> c) & 1u) ? c15 : NEG; P1_[r] = ((hi_ >> c) & 1u) ? c15 : NEG; } } \
            else { const float* tq_ = tb + (kb_ - (qlo + r32) + 4 * hi + 1023); \
                _Pragma("unroll") for (int r = 0; r < 16; ++r) { const int c = (r & 3) + 8 * (r >> 2); const float b0_ = tq_[c], b1_ = tq_[c + 32]; P0_[r] = ((lo_ >> c) & 1u) ? b0_ : NEG; P1_[r] = ((hi_ >> c) & 1u) ? b1_ : NEG; } } \
            if ((t) + 1 < NT) mw_nxt = mrow[j_lo + (t) + 1]; \
        } else { const float* dq_ = dkb + (t) * 64 + 4 * hi; \
            _Pragma("unroll") for (int g = 0; g < 4; ++g) { const f32x4 a_ = *(const f32x4*)(dq_ + 8 * g), b_ = *(const f32x4*)(dq_ + 32 + 8 * g); \
                P0_[4 * g] = a_[0]; P0_[4 * g + 1] = a_[1]; P0_[4 * g + 2] = a_[2]; P0_[4 * g + 3] = a_[3]; P1_[4 * g] = b_[0]; P1_[4 * g + 1] = b_[1]; P1_[4 * g + 2] = b_[2]; P1_[4 * g + 3] = b_[3]; } } \
    } while (0)
#define PNEXT() do { if constexpr (MODE == 0) mw_cur = mw_nxt; } while (0)
#define MASKT(P0_, P1_, t) do { if constexpr (MODE == 1) { const int kb_ = KBASE(t); if (kb_ + KVBLK - 1 > qlo) mask_tile(P0_, P1_, lr, qlo - kb_); } } while (0)
#define DKLOAD(t) do { } while (0)
#define DKWRITE(bf) do { } while (0)
#define QKT(KB_, P0_, P1_) do { if constexpr (MODE == 0) qkt8<KB_>(P0_, P1_, K_lds, r32, hi, S.qr); else qkt<KB_>(P0_, P1_, K_lds, r32, hi, S.qr); } while (0)
    constexpr int NQL = (MODE == 0) ? 4 : 8;
#define SEAM_K0() do { VMWN(NQL); SWRITE_HK(0); SBAR(); } while (0)
    f32x16 pA0, pA1, pB0, pB1; float mnA, mnB, alA, alB; bf16x8 pa0, pa1, pa2, pa3;
    SWRITE_HV(0); SBAR();
    __syncthreads();
    if (NT > 1) { SLOAD_H(Kh, Vh, KBASE(1)); DKLOAD(1); }
    SBAR(); PINIT(pA0, pA1, 0, 0); QKT(0, pA0, pA1); PNEXT();
    MASKT(pA0, pA1, 0); PSM(pA0, pA1, mnA, alA);
    if (NT > 1) { VMW(); SWRITE_HV(1); SWRITE_HK(1); DKWRITE(1); }
    __syncthreads();
#define HALF_STEP(PX0, PX1, mnX, alX, PY0, PY1, alY, t, KB, VB, SB) do { \
        SBAR(); PINIT(PX0, PX1, t, KB); QKT(KB, PX0, PX1); \
        FIN(PY0, PY1, alY); SBAR(); \
        if ((t) + 1 < NT) { SLOAD_H(Kh, Vh, KBASE((t) + 1)); DKLOAD((t) + 1); SBAR(); } \
        PVT(VB); MASKT(PX0, PX1, (t)); PSM(PX0, PX1, mnX, alX); \
        __syncthreads(); \
        if ((t) + 1 < NT) { VMW(); SWRITE_HV(SB); SWRITE_HK(SB); DKWRITE(SB); } \
        PNEXT(); RESC(alX); __syncthreads(); } while (0)
    for (int t = 1; t + 1 < NT; t += 2) {
        HALF_STEP(pB0, pB1, mnB, alB, pA0, pA1, alA, t, 1, 0, 0);
        HALF_STEP(pA0, pA1, mnA, alA, pB0, pB1, alB, t + 1, 0, 1, 1);
    }
    const bool even = (NT & 1) == 0;
    if (even) { SBAR(); PINIT(pB0, pB1, NT - 1, 1); QKT(1, pB0, pB1); PNEXT(); SBAR(); }
    VMW();
    SLOAD_H(nxt.K, nxt.V, kbn); SBAR();
    { int qo_ = (wid * QBLK + r32) * LD; asm volatile("" : "+v"(qo_));
      if constexpr (MODE == 0) { const char* q8_ = (const char*)nxt.Q + qo_ + 32 * hi; S.qr[0] = *(const bf16x8*)(q8_); S.qr[1] = *(const bf16x8*)(q8_ + 16); S.qr[2] = *(const bf16x8*)(q8_ + 64); S.qr[3] = *(const bf16x8*)(q8_ + 80); }
      else {
#pragma unroll
        for (int d0 = 0; d0 < 8; ++d0) S.qr[d0] = *(const bf16x8*)(nxt.Q + qo_ + hi * 8 + d0 * 16); } }
    SBAR();
    FIN(pA0, pA1, alA); SBAR();
    PVT(0);
    if (even) { MASKT(pB0, pB1, NT - 1); PSM(pB0, pB1, mnB, alB); __syncthreads(); RESC(alB);
        FIN(pB0, pB1, alB); SBAR(); PVT(1); }
    SBAR(); SEAM_K0();
    if (hi == 0) li_l[r32] = l_reg; asm volatile("s_waitcnt lgkmcnt(0)" ::: "memory");
    float rli[16];
#pragma unroll
    for (int r = 0; r < 16; ++r) rli[r] = __builtin_amdgcn_rcpf(li_l[crow(r, hi)]);
    int oo_ = (wid * QBLK + 4 * hi) * LD + r32; asm volatile("" : "+v"(oo_));
    unsigned char* Ow = (unsigned char*)cur.O + oo_;
#pragma unroll
    for (int r = 0; r < 16; ++r) { const int orow = (r & 3) + 8 * (r >> 2);
#pragma unroll
        for (int d0 = 0; d0 < 4; ++d0) { const float v = o[d0][r] * (rli[r] * 16.f); const float vn = __shfl_xor(v, 1);
            if ((r32 & 1) == 0) *(unsigned short*)(Ow + orow * LD + d0 * 32) = (unsigned short)__builtin_amdgcn_cvt_pk_fp8_f32(v, vn, 0, false); } }
    __syncthreads();
#undef RESC
#undef KBASE
#undef PINIT
#undef PNEXT
#undef MASKT
#undef DKLOAD
#undef DKWRITE
#undef SEAM_K0
#undef HALF_STEP
#undef QKT
#undef FIN
#undef PVT
#undef PSM
}
#undef AROW
#undef VMW
#undef VMWN
#undef SLOAD_H
#undef SWRITE_HK
#undef SWRITE_HV
#undef KSWZ
#undef K8SWZ
#undef V8SWZ
#undef QLOAD
#undef SBAR
}

constexpr float FOX_SKIP = -40.0f;
__device__ __forceinline__ int fox_jlo(Frame& F, int bh, int qb) {
    const float* kn = (const float*)(F.ws + WS_NORM) + (size_t)bh * 128; const float* qn = (const float*)(F.ws + WS_NORM) + (size_t)(BATCH * NH + bh) * 128;
    const float* cum = (const float*)(F.ws + WS_CUM) + (size_t)bh * SEQ;
    const int j0 = 4 * qb, lane = F.lane;
    const float Qm = fmaxf(fmaxf(qn[j0], qn[j0 + 1]), fmaxf(qn[j0 + 2], qn[j0 + 3])), Kd = fmaxf(fmaxf(kn[j0], kn[j0 + 1]), fmaxf(kn[j0 + 2], kn[j0 + 3]));
    const float c0 = cum[256 * qb];
    bool keep0 = true, keep1 = true;
    if (lane < j0) keep0 = !(Qm * (kn[lane] + Kd) * ATT_SCALE + (c0 - cum[64 * lane + 63]) < FOX_SKIP);
    if (64 + lane < j0) keep1 = !(Qm * (kn[64 + lane] + Kd) * ATT_SCALE + (c0 - cum[64 * (64 + lane) + 63]) < FOX_SKIP);
    const unsigned long long m0 = __ballot(keep0), m1 = __ballot(keep1);
    const int jl = m0 ? __builtin_ctzll(m0) : 64 + __builtin_ctzll(m1);
    return __builtin_amdgcn_readfirstlane(jl);
}
template <int MODE>
__device__ __forceinline__ att::BlockRef p4_ref(Frame& F, int L, int jlo) {
    const int xcd = L & 7, k = (L >> 3) & 31, i = L >> 8, bh = 4 * xcd + ((MODE == 1) ? (((k >> 3) + i) & 3) : (k >> 3)), p = k & 7, b = bh >> 4, h = bh & 15;
    const int qb = (i == 0) ? p : (i == 1) ? 31 - p : (i == 2) ? 8 + p : 23 - p;
    bf16* E = (bf16*)(F.ws + WS_E); const size_t TS = (size_t)M * DA;
    att::BlockRef r; const size_t rowq = (size_t)b * SEQ + (size_t)qb * 256, rowk = (size_t)b * SEQ;
    if constexpr (MODE == 0) { r.Q = (const bf16*)(F.ws + WS_E + rowq * DA + h * HD); r.O = (bf16*)(F.ws + WS_Y8A + rowq * DA + h * HD); r.K = (const bf16*)(F.ws + WS_E + 2 * ACT2K + rowk * DA + h * HD); r.V = (const bf16*)(F.ws + WS_E + 3 * ACT2K + rowk * DA + h * HD); }
    else { r.Q = E + TS + rowq * DA + h * HD; r.O = (bf16*)(F.ws + WS_Y8B + rowq * DA + h * HD); r.K = E + 4 * TS + rowk * DA + h * HD; r.V = E + 5 * TS + rowk * DA + h * HD; }
    r.P0 = qb * 256; r.jlo = jlo;
    r.MK = (const unsigned long long*)(F.ws + WS_MASK) + rowq * 128; r.cum = (const float*)(F.ws + WS_CUM) + (size_t)(b * NH + h) * SEQ;
    return r;
}
__device__ __forceinline__ void p4_decode(int L, int mode, int& bh, int& qb) {
    const int xcd = L & 7, k = (L >> 3) & 31, i = L >> 8, p = k & 7;
    bh = 4 * xcd + (mode ? (((k >> 3) + i) & 3) : (k >> 3)); qb = (i == 0) ? p : (i == 1) ? 31 - p : (i == 2) ? 8 + p : 23 - p;
}
template <int MODE>
__device__ __forceinline__ void p4_attention_branch(Frame& F, char* lds) {
    const int G = F.G; int L = blockIdx.x; if (L >= 1024) return;
    int jl[4] = {0, 0, 0, 0};
    if constexpr (MODE == 1) {
#pragma unroll
        for (int i = 0; i < 4; ++i) { const int Li = L + i * G; if (Li < 1024) { int bh, qb; p4_decode(Li, 1, bh, qb); jl[i] = fox_jlo(F, bh, qb); } }
    }
    int bi = 0;
    att::BlockRef cur = p4_ref<MODE>(F, L, jl[0]); att::Seam S;
    att::attn_prime<MODE>(cur, lds, S);
    for (;;) {
        const bool last = L + G >= 1024 || bi >= 3; const int Ln = last ? L : L + G;
        const int jn = (bi == 0) ? jl[1] : (bi == 1) ? jl[2] : jl[3];
        const att::BlockRef nxt = last ? cur : p4_ref<MODE>(F, Ln, jn);
        int bh, qb; p4_decode(L, MODE, bh, qb);
        att::attn_block<MODE>(cur, nxt, F.rel_bias + (bh & 15), lds, S);
        if (last) break;
        cur = nxt; L = Ln; ++bi;
    }
}

template <bool TO_BF16>
__device__ __forceinline__ void rmsnorm_rows(Frame& F, const float* src, const float* g, float* dstf, bf16* dstb) {
    const int gw = F.vcu * NWAVES + F.wave, NGW = F.G * NWAVES;
    for (int m = gw; m < M; m += NGW) {
        const GAS f32x4* xr = (const GAS f32x4*)(src + (size_t)m * DM) + F.lane; const GAS f32x4* gr = (const GAS f32x4*)g + F.lane;
        f32x4 v[16]; float s = 0.f;
#pragma unroll
        for (int j = 0; j < 16; ++j) { v[j] = xr[64 * j]; s += (v[j].x * v[j].x + v[j].y * v[j].y) + (v[j].z * v[j].z + v[j].w * v[j].w); }
        const float rstd = 1.0f / sqrtf(wave_sum(s) * (1.f / DM) + EPS);
        if constexpr (TO_BF16) { GAS unsigned long long* o8 = (GAS unsigned long long*)(dstb + (size_t)m * DM) + F.lane;
#pragma unroll
            for (int j = 0; j < 16; ++j) { const f32x4 gg = gr[64 * j];
                o8[64 * j] = (unsigned long long)pk2bf(v[j].x * rstd * gg.x, v[j].y * rstd * gg.y) | ((unsigned long long)pk2bf(v[j].z * rstd * gg.z, v[j].w * rstd * gg.w) << 32); } }
        else { GAS f32x4* o = (GAS f32x4*)(dstf + (size_t)m * DM) + F.lane;
#pragma unroll
            for (int j = 0; j < 16; ++j) { const f32x4 gg = gr[64 * j]; o[64 * j] = v[j] * rstd * gg; } }
    }
}

__device__ __forceinline__ void final_norm_rows(Frame& F, const bf16* src, const float* g, float* dst) {
    const int gw = F.vcu * NWAVES + F.wave, NGW = F.G * NWAVES;
    for (int m = gw; m < M; m += NGW) {
        const GAS v4u* xr = (const GAS v4u*)(src + (size_t)m * DM) + F.lane; const GAS f32x4* gr = (const GAS f32x4*)g + 2 * F.lane;
        v4u v[8]; float s = 0.f;
#pragma unroll
        for (int j = 0; j < 8; ++j) v[j] = xr[64 * j];
#pragma unroll
        for (int j = 0; j < 8; ++j) { const float a0 = pg8::bf_lo(v[j].x), a1 = pg8::bf_hi(v[j].x), a2 = pg8::bf_lo(v[j].y), a3 = pg8::bf_hi(v[j].y), a4 = pg8::bf_lo(v[j].z), a5 = pg8::bf_hi(v[j].z), a6 = pg8::bf_lo(v[j].w), a7 = pg8::bf_hi(v[j].w);
            s += ((a0 * a0 + a1 * a1) + (a2 * a2 + a3 * a3)) + ((a4 * a4 + a5 * a5) + (a6 * a6 + a7 * a7)); }
        const float rstd = 1.0f / sqrtf(wave_sum(s) * (1.f / DM) + EPS);
        GAS f32x4* o = (GAS f32x4*)(dst + (size_t)m * DM) + 2 * F.lane;
#pragma unroll
        for (int j = 0; j < 8; ++j) { const f32x4 g0 = gr[128 * j], g1 = gr[128 * j + 1];
            f32x4 y0 = {pg8::bf_lo(v[j].x), pg8::bf_hi(v[j].x), pg8::bf_lo(v[j].y), pg8::bf_hi(v[j].y)}, y1 = {pg8::bf_lo(v[j].z), pg8::bf_hi(v[j].z), pg8::bf_lo(v[j].w), pg8::bf_hi(v[j].w)};
            o[128 * j] = y0 * rstd * g0; o[128 * j + 1] = y1 * rstd * g1; }
    }
}

constexpr int N_PHASES = 12;
struct Args { const float* in[12]; float* out; unsigned char* ws; int ph_lo, ph_hi, li, pad; };
__global__ void __launch_bounds__(NWAVES * 64, 2) fwd(Args args) {
    extern __shared__ __attribute__((aligned(16))) unsigned char lds[];
    Frame F;
    F.lds = (LAS unsigned char*)lds;
    F.MISC = (volatile LAS unsigned*)(F.lds + MISC_OFF);
    F.tid = threadIdx.x; F.lane = F.tid & 63; F.wave = __builtin_amdgcn_readfirstlane(F.tid >> 6);
    F.G = gridDim.x; { const int bx = blockIdx.x; F.vcu = (F.G % 8 == 0) ? (bx % 8) * (F.G / 8) + bx / 8 : bx; }
    F.ws = args.ws; F.ctl = (gu32*)(args.ws + WS_CTL);
    F.x = args.in[0]; F.w_in = args.in[1]; F.b_f = args.in[2]; F.w_out_a = args.in[3]; F.w_out_b = args.in[4]; F.w_o = args.in[5]; F.w_up = args.in[6]; F.w_down = args.in[7];
    F.g_mix = args.in[8]; F.g_mlp = args.in[9]; F.g_final = args.in[10]; F.rel_bias = args.in[11]; F.out = args.out;
    for (int u = F.tid; u < (LDS_BYTES - LDSCTL_OFF) / 4; u += NWAVES * 64) ((LAS unsigned*)(F.lds + LDSCTL_OFF))[u] = 0u;
    __syncthreads();
    XcdBarrier bar = xcd_barrier_post((unsigned*)(F.ctl + CW_BAR) + args.li * XCD_BAR_WORDS, F.MISC + 8);
    const int lo = args.ph_lo, hi = args.ph_hi;
#define IN(k) (lo <= (k) && (k) < hi)
#define SEAM(k) do { if (IN(k) && IN((k) + 1)) xcd_barrier(bar); } while (0)
#define LANES() do { int t_ = threadIdx.x; asm volatile("" : "+v"(t_)); F.tid = t_; F.lane = t_ & 63; } while (0)
    unsigned char* ws = args.ws;
    if (IN(0)) { LANES(); p0_prologue(F); } SEAM(0);
    if (IN(1)) { LANES();
        { pg8::Gemm g{(const bf16*)(ws + WS_XN8), (const bf16*)(ws + WS_WIN8), M, DST_IQ, DM / 2}; pg8::StaticOrder S; S.init(M, DST_IQ, F.G, (int)blockIdx.x);
          EpiInProj<0> E{ws, F.b_f, 0, 1.0f / 64.0f};
          pg8::gemm_phase<EpiInProj<0>, pg8::StaticOrder, 2>(F.lds + RING_OFF, g, S, E); }
        pg8::Gemm g{(const bf16*)(ws + WS_XN), (const bf16*)(ws + WS_WINH), M, NPAD - DST_IQ, DM}; pg8::StaticOrder S; S.init(M, NPAD - DST_IQ, F.G, (int)blockIdx.x);
        EpiInProj<1> E{ws, F.b_f, TILE_IQ0, 1.0f};
        pg8::gemm_phase<EpiInProj<1>, pg8::StaticOrder, 1>(F.lds + RING_OFF, g, S, E);
        { const int nunits = (M / 256) * (NPAD / 256), nlast = nunits % F.G, nidle = F.G - nlast;
          if (nlast == 0) p1_convert_small_weights(F, (int)blockIdx.x, F.G);
          else if ((int)blockIdx.x >= nlast) p1_convert_small_weights(F, (int)blockIdx.x - nlast, nidle); }
    } SEAM(1);
    if (IN(2)) { LANES(); p2_scores(F); __syncthreads(); p2_index_select(F); } SEAM(2);
    if (IN(4)) { LANES(); p4_attention_branch<0>(F, (char*)lds + RING_OFF); __syncthreads(); p4_attention_branch<1>(F, (char*)lds + RING_OFF); } SEAM(4);
    if (IN(5)) { LANES();
        { const int nunits = (M / 256) * (NPAD / 256), nlast = nunits % F.G, nidle = (nlast == 0) ? F.G : F.G - nlast; constexpr int I_UP = (DM / 64) * (DFF / 64);
          const int nearly = UP_EARLY_PER_WAVE * nidle * NWAVES; p5_convert_mlp_weights(F, nearly < I_UP ? nearly : I_UP); } __syncthreads();
        pg8::Gemm g{(const bf16*)(ws + WS_Y8A), (const bf16*)(ws + WS_WOA), M, DM, DA / 2}; pg8::StaticOrder S; S.init(M, DM, F.G, (int)blockIdx.x);
        EpiGate<false> E{ws + WS_GA, nullptr, (bf16*)(ws + WS_T), 1.0f / 1024.0f};
        pg8::gemm_phase<EpiGate<false>, pg8::StaticOrder, 2>(F.lds + RING_OFF, g, S, E);
    }
    if (IN(6)) { LANES();
        pg8::Gemm g{(const bf16*)(ws + WS_Y8B), (const bf16*)(ws + WS_WOB), M, DM, DA / 2}; pg8::StaticOrder S; S.init(M, DM, F.G, (int)blockIdx.x);
        EpiGate<true> E{ws + WS_GB, (bf16*)(ws + WS_T), (bf16*)(ws + WS_MERGED), 1.0f / 1024.0f};
        pg8::gemm_phase<EpiGate<true>, pg8::StaticOrder, 2>(F.lds + RING_OFF, g, S, E);
    } SEAM(6);
    if (IN(7)) { LANES();
        pg8::Gemm g{(const bf16*)(ws + WS_MERGED), (const bf16*)(ws + WS_WO), M, DM, DM / 2}; pg8::StaticOrder S; S.init(M, DM, F.G, (int)blockIdx.x);
        EpiResidNorm E{F.x, (bf16*)(ws + WS_X1B), (float*)(ws + WS_SSP), 1.0f / 1024.0f};
        pg8::gemm_phase<EpiResidNorm, pg8::StaticOrder, 2>(F.lds + RING_OFF, g, S, E);
    } SEAM(7);
    if (IN(9)) { LANES();
        pg8::Gemm g{(const bf16*)(ws + WS_X1B), (const bf16*)(ws + WS_WUP), M, DFF, DM}; pg8::StaticOrder S; S.init(M, DFF, F.G, (int)blockIdx.x);
        EpiUp E{(bf16*)(ws + WS_H), (const float*)(ws + WS_SSP), (LAS float*)(F.lds + RSTD_LDS_OFF), -1};
        pg8::gemm_phase<EpiUp, pg8::StaticOrder, 0>(F.lds + RING_OFF, g, S, E);
    } SEAM(9);
    if (IN(10)) { LANES();
        pg8::Gemm g{(const bf16*)(ws + WS_H), (const bf16*)(ws + WS_WDN), M, DM, DFF}; pg8::StaticOrder S; S.init(M, DM, F.G, (int)blockIdx.x, 4);
        EpiResid E{(const bf16*)(ws + WS_X1B), (bf16*)(ws + WS_X2B)};
        pg8::gemm_phase<EpiResid, pg8::StaticOrder, 0>(F.lds + RING_OFF, g, S, E);
    } SEAM(10);
    if (IN(11)) { LANES(); final_norm_rows(F, (const bf16*)(ws + WS_X2B), F.g_final, F.out); }
#undef IN
#undef SEAM
}

#ifndef MK_N_LAUNCHES
#define MK_N_LAUNCHES 1
#endif
extern "C" void kernel_launch(void* const* d_in, const int* in_sizes, int n_in, void* d_out, int out_size, void* d_ws, size_t ws_size, hipStream_t stream) {
    static int grid = 0;
    if (grid == 0) {
        if (n_in != 12 || out_size != M * DM || ws_size < WS_END) { fprintf(stderr, "kernel_launch: unexpected shapes / workspace (n_in %d out %d ws %zu, need %zu)\n", n_in, out_size, ws_size, (size_t)WS_END); grid = -1; return; }
        int dev = 0, cus = 0, per_cu = 0;
        if (hipGetDevice(&dev) != hipSuccess || hipDeviceGetAttribute(&cus, hipDeviceAttributeMultiprocessorCount, dev) != hipSuccess) { grid = -1; return; }
        if (hipFuncSetAttribute((const void*)fwd, hipFuncAttributeMaxDynamicSharedMemorySize, LDS_BYTES) != hipSuccess) { fprintf(stderr, "kernel_launch: hipFuncSetAttribute failed\n"); grid = -1; return; }
        if (hipOccupancyMaxActiveBlocksPerMultiprocessor(&per_cu, (const void*)fwd, NWAVES * 64, LDS_BYTES) != hipSuccess || per_cu < 1) { fprintf(stderr, "kernel_launch: occupancy query reports %d\n", per_cu); }
        (void)hipGetLastError();
        grid = cus;
    }
    if (grid < 0) return;
    if (hipMemsetAsync((char*)d_ws + WS_CTL, 0, CTL_ZERO_BYTES, stream) != hipSuccess) return;
    Args a{};
    for (int i = 0; i < 12; ++i) a.in[i] = (const float*)d_in[i];
    a.out = (float*)d_out; a.ws = (unsigned char*)d_ws; a.pad = 0;
#if MK_N_LAUNCHES == 1
    a.ph_lo = 0; a.ph_hi = N_PHASES; a.li = 0;
    hipLaunchKernelGGL(fwd, dim3(grid), dim3(NWAVES * 64), LDS_BYTES, stream, a);
#else
    for (int p = 0; p < N_PHASES; ++p) { a.ph_lo = p; a.ph_hi = p + 1; a.li = 0; hipLaunchKernelGGL(fwd, dim3(grid), dim3(NWAVES * 64), LDS_BYTES, stream, a); }
#endif
}
```

```cpp
#include <hip/hip_runtime.h>
#include <cstdio>
#include <cstdint>

namespace pg8 {
#define PG8_LAS __attribute__((address_space(3)))
typedef unsigned short bf16_t;
typedef short bf16x8 __attribute__((ext_vector_type(8)));
typedef _Float16 f16x8 __attribute__((ext_vector_type(8)));
typedef float f32x4 __attribute__((ext_vector_type(4)));
typedef float f32x2 __attribute__((ext_vector_type(2)));
typedef unsigned u32x4 __attribute__((ext_vector_type(4)));
typedef unsigned u32x2 __attribute__((ext_vector_type(2)));
typedef int i32x4 __attribute__((ext_vector_type(4)));
typedef int i32x8 __attribute__((ext_vector_type(8)));
constexpr int BM = 256, BK = 64, HALF = 128, HTB = HALF * BK * 2, STAGE_BYTES = 8 * HTB, NXCD = 8, WGM = 8;

__host__ __device__ __forceinline__ int lds_byte(int r, int c) { const int st = (r >> 4) * 2 + (c >> 5), rr = r & 15, cc = c & 31, ob = rr * 64 + cc * 2; return st * 1024 + (ob ^ (((ob >> 9) & 1) << 5)); }
__host__ __device__ __forceinline__ void stage_rc(int b, int& R, int& C) { const int st = b / 1024, sb = b % 1024, swz = sb ^ (((sb >> 9) & 1) << 5); R = (st >> 1) * 16 + swz / 64; C = (st & 1) * 32 + (swz % 64) / 2; }
__host__ __device__ __forceinline__ int perm32(int rho) { const int n = rho >> 4, i = rho & 15; return 8 * (i >> 2) + 4 * n + (i & 3); }

struct Unit { int pm, pn; };
struct Gemm { const bf16_t* A; const bf16_t* Bt; int M, N, K; };

struct StaticOrder {
    int nM, nN, nwg, G, c, wgm;
    __host__ __device__ void init(int M, int N, int G_, int c_, int wgm_ = WGM) { nM = M / BM; nN = N / BM; nwg = nM * nN; G = G_; c = c_; wgm = wgm_; }
    __host__ __device__ bool next(int i, Unit& u) const {
        const long L = (long)i * G + c; if (L >= nwg) return false;
        int wgid = (int)L; { const int q = nwg / NXCD, r = nwg % NXCD, xcd = wgid % NXCD, off = wgid / NXCD; wgid = (xcd < r ? xcd * (q + 1) : r * (q + 1) + (xcd - r) * q) + off; }
        const int nig = wgm * nN, gid = wgid / nig, fm = gid * wgm, gsz = (nM - fm) < wgm ? (nM - fm) : wgm;
        u.pm = fm + ((wgid % nig) % gsz); u.pn = (wgid % nig) / gsz; return true;
    }
    __device__ __forceinline__ void a_ready(const Unit&) const {}
    __device__ __forceinline__ void done(const Unit&) const {}
};
typedef __bf16 bf16x2_t __attribute__((ext_vector_type(2)));
__device__ __forceinline__ unsigned cvt_pk_bf16(float lo, float hi) { f32x2 v = {lo, hi}; return __builtin_bit_cast(unsigned, __builtin_convertvector(v, bf16x2_t)); }
__device__ __forceinline__ unsigned cvt_pk_f16(float lo, float hi) { typedef _Float16 h2 __attribute__((ext_vector_type(2))); h2 v; v.x = (_Float16)lo; v.y = (_Float16)hi; return __builtin_bit_cast(unsigned, v); }
__device__ __forceinline__ float bf_lo(unsigned w) { return __builtin_bit_cast(float, w << 16); }
__device__ __forceinline__ float bf_hi(unsigned w) { return __builtin_bit_cast(float, w & 0xffff0000u); }

template <class Epi, class Sched, int MT  , bool ALIGN_EPI = true, bool SP2 = true, bool KREV = false>
__device__ __forceinline__ void gemm_phase(PG8_LAS unsigned char* lds, const Gemm g, const Sched& S, const Epi& E) {
    int tid_ = threadIdx.x; asm volatile("" : "+v"(tid_));
    const int tid = tid_, wid = __builtin_amdgcn_readfirstlane(tid >> 6), lane = tid & 63, wr = wid >> 2, wc = wid & 3, fr = lane & 15, fq = lane >> 4;
    const int K = g.K, nt = K / BK;
    unsigned voffA[2], voffB[2];
#pragma unroll
    for (int i = 0; i < 2; ++i) { int R, C; stage_rc(tid * 16 + i * 8192, R, C); const int Rb = Epi::PERM ? ((R & ~31) + perm32(R & 31)) : R;
        voffA[i] = (unsigned)(R * K + C) * 2u; voffB[i] = (unsigned)(Rb * K + C) * 2u; }
    const ptrdiff_t kstep = KREV ? -(ptrdiff_t)(BK * 2) : (ptrdiff_t)(BK * 2);
    const size_t krev0 = KREV ? (size_t)(nt - 1) * (BK * 2) : 0;
    const size_t hstep = (size_t)HALF * K * 2;
    const size_t tstep = 2 * hstep;
    const unsigned ldsw = (unsigned)wid * 1024u;
    const int aoff = lds_byte(wr * 64 + fr, fq * 8), boff = lds_byte(wc * 32 + fr, fq * 8);
#define PG8_SA(b, h) (((b) * 2 + (h)) * HTB)
#define PG8_SB(b, h) ((4 + (b) * 2 + (h)) * HTB)
#define PG8_STAGE(bufoff, gbase, voff) do { _Pragma("unroll") for (int _i = 0; _i < 2; ++_i) \
        __builtin_amdgcn_global_load_lds((const unsigned*)((const char*)(gbase) + (voff)[_i]), (PG8_LAS unsigned*)(lds + (bufoff) + ldsw + _i * 8192), 16, 0, 0); } while (0)
#define PG8_LDA(dst, b, h) do { _Pragma("unroll") for (int m = 0; m < 4; ++m) _Pragma("unroll") for (int k = 0; k < 2; ++k) dst[m][k] = *(const PG8_LAS bf16x8*)(lds + PG8_SA(b, h) + aoff + m * 2048 + k * 1024); } while (0)
#define PG8_LDB(dst, b, h) do { _Pragma("unroll") for (int n = 0; n < 2; ++n) _Pragma("unroll") for (int k = 0; k < 2; ++k) dst[n][k] = *(const PG8_LAS bf16x8*)(lds + PG8_SB(b, h) + boff + n * 2048 + k * 1024); } while (0)
#define PG8_MMA(ai, bj, At, Bt) do { __builtin_amdgcn_s_setprio(1); _Pragma("unroll") for (int m = 0; m < 4; ++m) _Pragma("unroll") for (int n = 0; n < 2; ++n) { \
        if constexpr (MT == 2) {   \
            const i32x8 b8_ = __builtin_shufflevector(__builtin_bit_cast(i32x4, Bt[n][0]), __builtin_bit_cast(i32x4, Bt[n][1]), 0, 1, 2, 3, 4, 5, 6, 7); \
            const i32x8 a8_ = __builtin_shufflevector(__builtin_bit_cast(i32x4, At[m][0]), __builtin_bit_cast(i32x4, At[m][1]), 0, 1, 2, 3, 4, 5, 6, 7); \
              \
            asm volatile("v_mfma_scale_f32_16x16x128_f8f6f4 %0, %1, %2, %0, %3, %3 op_sel_hi:[0,0,0]" : "+v"(acc[ai][bj][m][n]) : "v"(b8_), "v"(a8_), "v"(0x7f7f7f7f)); } \
        else { _Pragma("unroll") for (int k = 0; k < 2; ++k) { \
        if constexpr (MT == 1) acc[ai][bj][m][n] = __builtin_amdgcn_mfma_f32_16x16x32_f16(__builtin_bit_cast(f16x8, Bt[n][k]), __builtin_bit_cast(f16x8, At[m][k]), acc[ai][bj][m][n], 0, 0, 0); \
        else acc[ai][bj][m][n] = __builtin_amdgcn_mfma_f32_16x16x32_bf16(Bt[n][k], At[m][k], acc[ai][bj][m][n], 0, 0, 0); } } } __builtin_amdgcn_s_setprio(0); } while (0)
#define PG8_WAIT_V(n) asm volatile("s_waitcnt vmcnt(" #n ")" ::: "memory")
#define PG8_WAIT_L(n) asm volatile("s_waitcnt lgkmcnt(" #n ")" ::: "memory")
#define PG8_BAR __builtin_amdgcn_s_barrier()
#define PG8_SCHED __builtin_amdgcn_sched_barrier(0)
    Unit cur, nxt; int ui = 0;
    if (!S.next(0, cur)) return;
    f32x4 acc[2][2][4][2];
#pragma unroll
    for (int a = 0; a < 2; ++a)
#pragma unroll
        for (int b = 0; b < 2; ++b)
#pragma unroll
            for (int m = 0; m < 4; ++m)
#pragma unroll
                for (int n = 0; n < 2; ++n) acc[a][b][m][n] = (f32x4){0.f, 0.f, 0.f, 0.f};
    bf16x8 At[4][2], B0[2][2], B1[2][2];
    const char* cA = (const char*)g.A + (size_t)cur.pm * tstep + krev0; const char* cB = (const char*)g.Bt + (size_t)cur.pn * tstep + krev0;
    S.a_ready(cur);
    if constexpr (SP2) {
        PG8_STAGE(PG8_SB(0, 0), cB, voffB); PG8_STAGE(PG8_SB(0, 1), cB + hstep, voffB); PG8_STAGE(PG8_SA(0, 0), cA, voffA); PG8_STAGE(PG8_SA(0, 1), cA + hstep, voffA);
        if (wr == 1) PG8_BAR;
        PG8_WAIT_V(2); PG8_BAR;
        PG8_STAGE(PG8_SB(1, 0), cB + kstep, voffB); PG8_STAGE(PG8_SA(1, 0), cA + kstep, voffA); PG8_STAGE(PG8_SB(1, 1), cB + hstep + kstep, voffB);
        PG8_WAIT_V(6); PG8_BAR;
    } else {
        PG8_STAGE(PG8_SB(0, 0), cB, voffB); PG8_STAGE(PG8_SA(0, 0), cA, voffA); PG8_STAGE(PG8_SB(0, 1), cB + hstep, voffB); PG8_STAGE(PG8_SA(0, 1), cA + hstep, voffA);
        if (wr == 1) PG8_BAR;
        PG8_WAIT_V(4); PG8_BAR;
        PG8_STAGE(PG8_SB(1, 0), cB + kstep, voffB); PG8_STAGE(PG8_SA(1, 0), cA + kstep, voffA); PG8_STAGE(PG8_SB(1, 1), cB + hstep + kstep, voffB);
        PG8_WAIT_V(6); PG8_BAR;
    }
    for (;;) {
        const bool has_next = S.next(ui + 1, nxt);
        const char* nA = has_next ? (const char*)g.A + (size_t)nxt.pm * tstep + krev0 : cA; const char* nB = has_next ? (const char*)g.Bt + (size_t)nxt.pn * tstep + krev0 : cB;
        for (int t = 0; t < nt; t += 2) {
            const bool last = (t == nt - 2);
            const char* a1 = cA + (ptrdiff_t)(t + 1) * kstep;
            const char* a2 = last ? nA : cA + (ptrdiff_t)(t + 2) * kstep; const char* b2 = last ? nB : cB + (ptrdiff_t)(t + 2) * kstep;
            const char* a3 = a2 + kstep; const char* b3 = b2 + kstep;
            if (last && has_next) S.a_ready(nxt);
            if constexpr (SP2) {
            PG8_LDB(B0, 0, 0); PG8_LDB(B1, 0, 1); PG8_SCHED; PG8_LDA(At, 0, 0); PG8_STAGE(PG8_SA(1, 1), a1 + hstep, voffA);
            PG8_WAIT_V(8); PG8_WAIT_L(0); PG8_BAR; PG8_MMA(0, 0, At, B0); PG8_MMA(0, 1, At, B1); PG8_BAR; PG8_SCHED;
            PG8_LDA(At, 0, 1); PG8_STAGE(PG8_SB(0, 0), b2, voffB); PG8_STAGE(PG8_SB(0, 1), b2 + hstep, voffB); PG8_STAGE(PG8_SA(0, 0), a2, voffA);
            PG8_WAIT_V(8); PG8_WAIT_L(0); PG8_BAR; PG8_MMA(1, 0, At, B0); PG8_MMA(1, 1, At, B1); PG8_BAR; PG8_SCHED;
            PG8_LDB(B0, 1, 0); PG8_LDB(B1, 1, 1); PG8_SCHED; PG8_LDA(At, 1, 0); PG8_STAGE(PG8_SA(0, 1), a2 + hstep, voffA);
            PG8_WAIT_V(8); PG8_WAIT_L(0); PG8_BAR; PG8_MMA(0, 0, At, B0); PG8_MMA(0, 1, At, B1); PG8_BAR; PG8_SCHED;
            PG8_LDA(At, 1, 1); PG8_STAGE(PG8_SB(1, 0), b3, voffB); PG8_STAGE(PG8_SB(1, 1), b3 + hstep, voffB); PG8_STAGE(PG8_SA(1, 0), a3, voffA);
            PG8_WAIT_V(8); PG8_WAIT_L(0); PG8_BAR; PG8_MMA(1, 0, At, B0); PG8_MMA(1, 1, At, B1); PG8_BAR; PG8_SCHED;
            } else {
            PG8_LDB(B0, 0, 0); PG8_SCHED; PG8_LDA(At, 0, 0); PG8_STAGE(PG8_SA(1, 1), a1 + hstep, voffA);
            PG8_WAIT_L(8); PG8_BAR; PG8_WAIT_L(0); PG8_MMA(0, 0, At, B0); PG8_BAR; PG8_SCHED;
            PG8_LDB(B1, 0, 1); PG8_STAGE(PG8_SB(0, 0), b2, voffB);
            PG8_BAR; PG8_WAIT_L(0); PG8_MMA(0, 1, At, B1); PG8_BAR;
            PG8_LDA(At, 0, 1); PG8_STAGE(PG8_SA(0, 0), a2, voffA);
            PG8_BAR; PG8_WAIT_L(0); PG8_MMA(1, 0, At, B0); PG8_BAR; PG8_SCHED;
            PG8_STAGE(PG8_SB(0, 1), b2 + hstep, voffB);
            PG8_WAIT_V(6); PG8_BAR; PG8_MMA(1, 1, At, B1); PG8_BAR;
            PG8_LDB(B0, 1, 0); PG8_SCHED; PG8_LDA(At, 1, 0); PG8_STAGE(PG8_SA(0, 1), a2 + hstep, voffA);
            PG8_WAIT_L(8); PG8_BAR; PG8_WAIT_L(0); PG8_MMA(0, 0, At, B0); PG8_BAR; PG8_SCHED;
            PG8_LDB(B1, 1, 1); PG8_STAGE(PG8_SB(1, 0), b3, voffB);
            PG8_BAR; PG8_WAIT_L(0); PG8_MMA(0, 1, At, B1); PG8_BAR;
            PG8_LDA(At, 1, 1); PG8_STAGE(PG8_SA(1, 0), a3, voffA);
            PG8_BAR; PG8_WAIT_L(0); PG8_MMA(1, 0, At, B0); PG8_BAR; PG8_SCHED;
            PG8_STAGE(PG8_SB(1, 1), b3 + hstep, voffB);
            PG8_WAIT_V(6); PG8_BAR; PG8_MMA(1, 1, At, B1); PG8_BAR;
            }
        }
        if constexpr (ALIGN_EPI) { if (wr == 0) PG8_BAR; }
        if constexpr (MT == 2) asm volatile("s_nop 15\n\ts_nop 15\n\ts_nop 15" ::: "memory");
        E(acc, cur, wr, wc, fr, fq);
        if (!has_next) break;
#pragma unroll
        for (int a = 0; a < 2; ++a)
#pragma unroll
            for (int b = 0; b < 2; ++b)
#pragma unroll
                for (int m = 0; m < 4; ++m)
#pragma unroll
                    for (int n = 0; n < 2; ++n) acc[a][b][m][n] = (f32x4){0.f, 0.f, 0.f, 0.f};
        cur = nxt; cA = nA; cB = nB; ++ui;
        if constexpr (ALIGN_EPI) { if (wr == 1) PG8_BAR; }
    }
    PG8_WAIT_V(0);
    if constexpr (!ALIGN_EPI) { if (wr == 0) PG8_BAR; }
    PG8_BAR;
#undef PG8_SA
#undef PG8_SB
#undef PG8_STAGE
#undef PG8_LDA
#undef PG8_LDB
#undef PG8_MMA
#undef PG8_WAIT_V
#undef PG8_WAIT_L
#undef PG8_BAR
#undef PG8_SCHED
}
}

constexpr int NWAVES = 8;
constexpr int BATCH = 2, SEQ = 8192, DM = 4096, M = BATCH * SEQ;
constexpr int HD = 128, NH = 16, DA = 2048, NIH = 32, IDIM = 64, DFF = 16384, TOPK = 256, CHUNK = 64, NCHUNK = SEQ / CHUNK;
constexpr int DIN = 22640, NPAD = 22784;
constexpr float EPS = 1e-6f;
constexpr float ATT_SCALE = 0.08838834764831845f;
constexpr float IW_SCALE = 0.125f * 0.17677669529663687f;
constexpr int SRC_QA = 0, SRC_KA = 2048, SRC_VA = 4096, SRC_IQ = 6144, SRC_IK = 8192, SRC_IW = 8256, SRC_QB = 8288, SRC_KB = 10336, SRC_VB = 12384, SRC_FL = 14432, SRC_GA = 14448, SRC_GB = 18544;
constexpr int DST_QKV = 0, DST_G = 12288, DST_IQ = 20480, DST_SP = 22528;
constexpr int TILE_G0 = DST_G / 256, TILE_IQ0 = DST_IQ / 256, TILE_SP = DST_SP / 256;

constexpr size_t MiB = 1u << 20;
constexpr size_t WS_CTL = 0, CTL_ZERO_BYTES = 64 * 1024;
constexpr size_t WS_MASK = 1 * MiB;
constexpr size_t WS_CUM = 17 * MiB;
constexpr size_t WS_MISC = 18 * MiB;
constexpr size_t WS_NORM = 19 * MiB;
constexpr size_t WS_CD = 20 * MiB;
constexpr size_t WS_WIN8 = WS_CD, WS_WINH = WS_CD + 80 * MiB, WS_XN8 = WS_CD + 98 * MiB, WS_XN = WS_CD + 162 * MiB, WS_SCORE = WS_CD, WS_WDN = WS_CD + 128 * MiB;
constexpr size_t WS_SSP = 280 * MiB, WS_RSTD = 284 * MiB;
constexpr size_t WS_B = 326 * MiB;
constexpr size_t WS_WOA = WS_B, WS_WOB = WS_B + 16 * MiB, WS_WO = WS_B + 32 * MiB;
constexpr size_t WS_E = 390 * MiB;
constexpr size_t ACT2K = 64 * MiB;
constexpr size_t WS_T = WS_E + 2 * ACT2K, WS_MERGED = WS_E + 4 * ACT2K;
constexpr size_t WS_F = 774 * MiB;
constexpr size_t WS_IQ = WS_F, WS_IK = WS_F + 64 * MiB, WS_IW = WS_F + 66 * MiB, WS_FL = WS_F + 68 * MiB;
constexpr size_t WS_H = WS_B;
constexpr size_t WS_G = 846 * MiB;
constexpr size_t WS_GA = WS_G, WS_GB = WS_G + 64 * MiB, WS_X2B = WS_G, WS_Y8A = WS_G + 128 * MiB, WS_Y8B = WS_G + 160 * MiB;
constexpr size_t WS_X1B = 1102 * MiB;
constexpr size_t WS_WUP = 1230 * MiB;
constexpr size_t WS_END = 1358 * MiB;
constexpr int UP_EARLY_PER_WAVE = 7;
static_assert(WS_H + (size_t)M * DFF * 2 <= WS_G && WS_F + 72 * MiB <= WS_G && WS_SCORE + 280 * MiB <= WS_B, "ws map");
constexpr int CW_TMO = 0, CW_BAR = 4096;
constexpr int CW_RSS1 = 16384, CW_RSS2 = 32768;

constexpr int RING_OFF = 0, RING_BYTES = 131072;
constexpr int LDSCTL_OFF = 143360, MISC_OFF = LDSCTL_OFF + 320;
constexpr int LDS_BYTES = 147456;

#define GAS __attribute__((address_space(1)))
#define LAS __attribute__((address_space(3)))
typedef unsigned short bf16;
typedef unsigned v4u __attribute__((ext_vector_type(4)));
typedef float f32x4 __attribute__((ext_vector_type(4)));
typedef float f32x16 __attribute__((ext_vector_type(16)));
typedef _Float16 f16x8 __attribute__((ext_vector_type(8)));
typedef GAS unsigned gu32;
#define RLX_AGENT __ATOMIC_RELAXED, __HIP_MEMORY_SCOPE_AGENT
#define LDS_WAIT() asm volatile("s_waitcnt lgkmcnt(0)" ::: "memory")
#define VM_WAIT() asm volatile("s_waitcnt vmcnt(0)" ::: "memory")
__device__ __forceinline__ unsigned f2bf(float f) { unsigned u = __builtin_bit_cast(unsigned, f); return (u + 0x7fffu + ((u >> 16) & 1u)) >> 16; }
__device__ __forceinline__ unsigned pk2bf(float lo, float hi) { return f2bf(lo) | (f2bf(hi) << 16); }
__device__ __forceinline__ unsigned pk2h(float lo, float hi) { return pg8::cvt_pk_f16(lo, hi); }
__device__ __forceinline__ float bf2f(bf16 b) { return __builtin_bit_cast(float, ((unsigned)b) << 16); }

#define XB_TMO      128
#define XB_XCNT(j)  (256  + 64 * (j))
#define XB_XSUB(j)  (1280 + 64 * (j))
#define XB_XGEN(j)  (2304 + 64 * (j))
#define XB_TOP      3328
#define XB_TOPGEN   3392
#define XCD_BAR_WORDS 3456
#define XB_SPIN_CAP (1u << 22)
__device__ __forceinline__ unsigned xb_ld(unsigned* p)              { return __hip_atomic_load(p, __ATOMIC_RELAXED, __HIP_MEMORY_SCOPE_AGENT); }
__device__ __forceinline__ unsigned xb_add(unsigned* p, unsigned v) { return __hip_atomic_fetch_add(p, v, __ATOMIC_RELAXED, __HIP_MEMORY_SCOPE_AGENT); }
__device__ __forceinline__ unsigned xb_xcc_id() { return (unsigned)__builtin_amdgcn_s_getreg((3 << 11) | 20) & 0xFu; }
#define XB_SPIN(cond, bar) do { unsigned _sp = 0; while (cond) { __builtin_amdgcn_s_sleep(1); \
    if ((++_sp & 255u) == 0u) { if (xb_ld(&(bar)[XB_TMO])) break; if (_sp > XB_SPIN_CAP) { atomicAdd(&(bar)[XB_TMO], 1u); break; } } } } while (0)
struct XcdBarrier { unsigned* bar; unsigned x; volatile LAS unsigned* st; };
__device__ __forceinline__ XcdBarrier xcd_barrier_post(unsigned* bar, volatile LAS unsigned* st) {
    XcdBarrier b; b.bar = bar; b.x = xb_xcc_id(); b.st = st;
    if (threadIdx.x == 0) (void)xb_add(&bar[XB_XCNT(b.x)], 1u);
    return b;
}
__device__ __forceinline__ void xcd_barrier_complete(unsigned* bar, unsigned x, unsigned& nloc, unsigned& nx) {
    const unsigned G = gridDim.x * gridDim.y * gridDim.z;
    unsigned sum, cnt, mine, sp = 0u;
    for (;;) {
        sum = 0u; cnt = 0u; mine = 0u;
#pragma unroll
        for (unsigned j = 0; j < 16; ++j) { const unsigned c = xb_ld(&bar[XB_XCNT(j)]); sum += c; cnt += (c > 0u) ? 1u : 0u; mine = (j == x) ? c : mine; }
        if (sum == G) break;
        __builtin_amdgcn_s_sleep(1);
        if ((++sp & 255u) == 0u) { if (xb_ld(&bar[XB_TMO])) break; if (sp > XB_SPIN_CAP) { atomicAdd(&bar[XB_TMO], 1u); break; } }
    }
    nloc = mine > 0u ? mine : 1u; nx = cnt > 0u ? cnt : 1u;
}
__device__ __forceinline__ void xcd_barrier(const XcdBarrier& b) {
    asm volatile("s_waitcnt vmcnt(0)" ::: "memory");
    __syncthreads();
    if (threadIdx.x == 0) {
        unsigned* bar = b.bar;
        __builtin_amdgcn_s_waitcnt(0);
        unsigned nloc = b.st[0], nx = b.st[1];
        if (nloc == 0u) { xcd_barrier_complete(bar, b.x, nloc, nx); b.st[0] = nloc; b.st[1] = nx; }
        const unsigned old = xb_add(&bar[XB_XSUB(b.x)], 1u);
        const unsigned gen = old / nloc;
        if (old + 1u == (gen + 1u) * nloc) {
            __builtin_amdgcn_fence(__ATOMIC_RELEASE, "agent");
            asm volatile("s_waitcnt vmcnt(0)" ::: "memory");
            const unsigned og = xb_add(&bar[XB_TOP], 1u);
            const unsigned tg = og / nx;
            if (og + 1u == (tg + 1u) * nx) xb_add(&bar[XB_TOPGEN], 1u);
            else XB_SPIN(xb_ld(&bar[XB_TOPGEN]) == tg, bar);
            __builtin_amdgcn_fence(__ATOMIC_ACQUIRE, "agent");
            xb_add(&bar[XB_XGEN(b.x)], 1u);
            asm volatile("s_waitcnt vmcnt(0)" ::: "memory");
        } else {
            XB_SPIN(xb_ld(&bar[XB_XGEN(b.x)]) == gen, bar);
            __builtin_amdgcn_fence(__ATOMIC_ACQUIRE, "agent");
            asm volatile("s_waitcnt vmcnt(0)" ::: "memory");
        }
    }
    __syncthreads();
}

struct Frame {
    LAS unsigned char* lds;
    volatile LAS unsigned* MISC;
    gu32* ctl;
    int tid, lane, wave, vcu, G;
    unsigned char* ws;
    const float *x, *w_in, *b_f, *w_out_a, *w_out_b, *w_o, *w_up, *w_down, *g_mix, *g_mlp, *g_final, *rel_bias;
    float* out;
};
__device__ __forceinline__ float wave_sum(float v) {
#pragma unroll
    for (int o = 1; o < 64; o <<= 1) v += __shfl_xor(v, o);
    return v;
}

template <bool F16>
__device__ __forceinline__ void transpose_item(const float* W, int K, int N, bf16* WT, int k0, int scol, int nvalid, int drow, const float* kscale, LAS float* scr, int lane) {
#pragma unroll 8
    for (int i = 0; i < 32; ++i) { const int kk = 2 * i + (lane >> 5); const int c = lane & 31;
        float v = (c < nvalid) ? W[(size_t)(k0 + kk) * N + scol + c] : 0.f; if (kscale) v *= kscale[k0 + kk]; scr[kk * 33 + c] = v; }
    LDS_WAIT(); asm volatile("" ::: "memory");
    const int c = lane & 7;
#pragma unroll
    for (int j = 0; j < 4; ++j) { const int n = (lane >> 3) + 8 * j; const LAS float* s = scr + (8 * c) * 33 + n;
        v4u o;
        if constexpr (F16) { o.x = pk2h(s[0 * 33], s[1 * 33]); o.y = pk2h(s[2 * 33], s[3 * 33]); o.z = pk2h(s[4 * 33], s[5 * 33]); o.w = pk2h(s[6 * 33], s[7 * 33]); }
        else { o.x = pk2bf(s[0 * 33], s[1 * 33]); o.y = pk2bf(s[2 * 33], s[3 * 33]); o.z = pk2bf(s[4 * 33], s[5 * 33]); o.w = pk2bf(s[6 * 33], s[7 * 33]); }
        *(GAS v4u*)(WT + (size_t)(drow + n) * K + k0 + 8 * c) = o; }
    LDS_WAIT(); asm volatile("" ::: "memory");
}
struct TpJob { const float* W; bf16* WT; int K, N, k0, scol, drow, f16; const float* ks; };
__device__ __forceinline__ void tp_load(const TpJob& J, f32x4 (&v)[16], int lane) {
    const float* p = J.W + (size_t)(J.k0 + (lane >> 4)) * J.N + J.scol + 4 * (lane & 15);
#pragma unroll
    for (int i = 0; i < 16; ++i) v[i] = *(const f32x4*)(p + (size_t)(4 * i) * J.N);
}
__device__ __forceinline__ void tp_store(const TpJob& J, const f32x4 (&v)[16], LAS float* scr, int lane) {
    { LAS float* d = scr + (lane >> 4) * 65 + 4 * (lane & 15);
#pragma unroll
      for (int i = 0; i < 16; ++i) { d[(4 * i) * 65 + 0] = v[i][0]; d[(4 * i) * 65 + 1] = v[i][1]; d[(4 * i) * 65 + 2] = v[i][2]; d[(4 * i) * 65 + 3] = v[i][3]; } }
    LDS_WAIT(); asm volatile("" ::: "memory");
    const int nl = lane >> 3, kc = lane & 7;
#pragma unroll
    for (int j = 0; j < 8; ++j) { const int n = nl + 8 * j; const LAS float* q = scr + (8 * kc) * 65 + n;
        v4u o;
        if (J.f16 == 1) { o.x = pk2h(q[0 * 65], q[1 * 65]); o.y = pk2h(q[2 * 65], q[3 * 65]); o.z = pk2h(q[4 * 65], q[5 * 65]); o.w = pk2h(q[6 * 65], q[7 * 65]); }
        else if (J.ks) { const f32x4 s0 = *(const f32x4*)(J.ks + J.k0 + 8 * kc), s1 = *(const f32x4*)(J.ks + J.k0 + 8 * kc + 4);
            o.x = pg8::cvt_pk_bf16(q[0 * 65] * s0[0], q[1 * 65] * s0[1]); o.y = pg8::cvt_pk_bf16(q[2 * 65] * s0[2], q[3 * 65] * s0[3]); o.z = pg8::cvt_pk_bf16(q[4 * 65] * s1[0], q[5 * 65] * s1[1]); o.w = pg8::cvt_pk_bf16(q[6 * 65] * s1[2], q[7 * 65] * s1[3]); }
        else { o.x = pg8::cvt_pk_bf16(q[0 * 65], q[1 * 65]); o.y = pg8::cvt_pk_bf16(q[2 * 65], q[3 * 65]); o.z = pg8::cvt_pk_bf16(q[4 * 65], q[5 * 65]); o.w = pg8::cvt_pk_bf16(q[6 * 65], q[7 * 65]); }
        if (J.f16 == 2) {
            int p0 = __builtin_amdgcn_cvt_pk_fp8_f32(q[0 * 65] * 64.f, q[1 * 65] * 64.f, 0, false); p0 = __builtin_amdgcn_cvt_pk_fp8_f32(q[2 * 65] * 64.f, q[3 * 65] * 64.f, p0, true);
            int p1 = __builtin_amdgcn_cvt_pk_fp8_f32(q[4 * 65] * 64.f, q[5 * 65] * 64.f, 0, false); p1 = __builtin_amdgcn_cvt_pk_fp8_f32(q[6 * 65] * 64.f, q[7 * 65] * 64.f, p1, true);
            *(GAS unsigned long long*)((GAS unsigned char*)J.WT + (size_t)(J.drow + n) * J.K + J.k0 + 8 * kc) = (unsigned long long)(unsigned)p0 | ((unsigned long long)(unsigned)p1 << 32); }
        else *(GAS v4u*)(J.WT + (size_t)(J.drow + n) * J.K + J.k0 + 8 * kc) = o; }
    LDS_WAIT(); asm volatile("" ::: "memory");
}
template <class Decode>
__device__ __forceinline__ void tp_run(Frame& F, int nitems, const Decode& dec, int gw, int NGW) {
    LAS float* scr = (LAS float*)(F.lds + RING_OFF + F.wave * 16640);
    f32x4 va[16], vb[16]; TpJob ja, jb;
    int it = gw; if (it >= nitems) return;
    ja = dec(it); tp_load(ja, va, F.lane);
    for (;;) {
        const int i1 = it + NGW; const bool h1 = i1 < nitems;
        if (h1) { jb = dec(i1); tp_load(jb, vb, F.lane); }
        tp_store(ja, va, scr, F.lane);
        if (!h1) break;
        const int i2 = i1 + NGW; const bool h2 = i2 < nitems;
        if (h2) { ja = dec(i2); tp_load(ja, va, F.lane); }
        tp_store(jb, vb, scr, F.lane);
        if (!h2) break;
        it = i2;
    }
}
__device__ __forceinline__ void win_group(int gi, int& scol, int& nvalid) {
    const int d = gi * 32; nvalid = 32;
    if (d < DST_G) { const int t = d / 2048, o = d % 2048; const int base = (t == 0) ? SRC_QA : (t == 1) ? SRC_QB : (t == 2) ? SRC_KA : (t == 3) ? SRC_VA : (t == 4) ? SRC_KB : SRC_VB; scol = base + o; }
    else if (d < DST_IQ) { const int o = d - DST_G; scol = (o < 4096) ? SRC_GA + o : SRC_GB + (o - 4096); }
    else if (d < DST_SP) { scol = SRC_IQ + (d - DST_IQ); }
    else { const int o = d - DST_SP; if (o < 64) scol = SRC_IK + o; else if (o < 96) scol = SRC_IW + (o - 64); else if (o < 128) { scol = SRC_FL; nvalid = 16; } else { scol = 0; nvalid = 0; } }
}
__device__ __forceinline__ void p0_prologue(Frame& F) {
    const int gw = F.vcu * NWAVES + F.wave, NGW = F.G * NWAVES;
    constexpr int G8 = DST_IQ / 64, GH = (DST_SP - DST_IQ) / 64 + 1;
    constexpr int I8 = (DM / 64) * G8, IH = (DM / 64) * GH;
    const float* w_in = F.w_in; unsigned char* ws = F.ws;
    tp_run(F, I8 + IH, [=](int r) {
        TpJob J; int scol, nv;
        if (r < I8) { const int gi = r % G8, kb = r / G8; win_group(2 * gi, scol, nv); J = TpJob{w_in, (bf16*)(ws + WS_WIN8), DM, DIN, 64 * kb, scol, 64 * gi, 2, nullptr}; return J; } r -= I8;
        { const int gi = r % GH, kb = r / GH; win_group(2 * (G8 + gi), scol, nv); J = TpJob{w_in, (bf16*)(ws + WS_WINH), DM, DIN, 64 * kb, scol, 64 * gi, 1, nullptr}; return J; }
    }, gw, NGW);
    { LAS float* scr = (LAS float*)(F.lds + RING_OFF + F.wave * 16640);
      for (int it = gw; it < 6 * (DM / 64); it += NGW) { const int gi = (DST_SP + 64) / 32 + it % 6, kb = it / 6; int scol, nv; win_group(gi, scol, nv);
          transpose_item<true>(F.w_in, DM, DIN, (bf16*)(F.ws + WS_WINH), 64 * kb, scol, nv, gi * 32 - DST_IQ, nullptr, scr, F.lane); } }
    for (int m = gw; m < M; m += NGW) {
        const GAS f32x4* xr = (const GAS f32x4*)(F.x + (size_t)m * DM) + F.lane;
        f32x4 v[16]; float s = 0.f;
#pragma unroll
        for (int j = 0; j < 16; ++j) { v[j] = xr[64 * j]; s += (v[j].x * v[j].x + v[j].y * v[j].y) + (v[j].z * v[j].z + v[j].w * v[j].w); }
        const float rstd = 1.0f / sqrtf(wave_sum(s) * (1.f / DM) + EPS);
        GAS unsigned long long* o8 = (GAS unsigned long long*)((bf16*)(F.ws + WS_XN) + (size_t)m * DM) + F.lane;
        const GAS f32x4* gr = (const GAS f32x4*)F.g_mix + F.lane;
        GAS unsigned* o4 = (GAS unsigned*)(F.ws + WS_XN8 + (size_t)m * DM) + F.lane;
#pragma unroll
        for (int j = 0; j < 16; ++j) { const f32x4 g = gr[64 * j];
            const float y0 = v[j].x * rstd * g.x, y1 = v[j].y * rstd * g.y, y2 = v[j].z * rstd * g.z, y3 = v[j].w * rstd * g.w;
            o8[64 * j] = (unsigned long long)pk2h(y0, y1) | ((unsigned long long)pk2h(y2, y3) << 32);
            int p8 = __builtin_amdgcn_cvt_pk_fp8_f32(y0, y1, 0, false); p8 = __builtin_amdgcn_cvt_pk_fp8_f32(y2, y3, p8, true);
            o4[64 * j] = (unsigned)p8; }
    }
}
__device__ __forceinline__ void p1_convert_small_weights(Frame& F, int widx, int nwg) {
    constexpr int I_OA = (DA / 64) * (DM / 64), I_O = (DM / 64) * (DM / 64);
    const float* w_oa = F.w_out_a; const float* w_ob = F.w_out_b; const float* w_o = F.w_o; unsigned char* ws = F.ws;
    tp_run(F, 2 * I_OA + I_O, [=](int r) {
        TpJob J;
        if (r < I_OA) { const int nb = r % (DM / 64), kb = r / (DM / 64); J = TpJob{w_oa, (bf16*)(ws + WS_WOA), DA, DM, 64 * kb, 64 * nb, 64 * nb, 2, nullptr}; return J; } r -= I_OA;
        if (r < I_OA) { const int nb = r % (DM / 64), kb = r / (DM / 64); J = TpJob{w_ob, (bf16*)(ws + WS_WOB), DA, DM, 64 * kb, 64 * nb, 64 * nb, 2, nullptr}; return J; } r -= I_OA;
        { const int nb = r % (DM / 64), kb = r / (DM / 64); J = TpJob{w_o, (bf16*)(ws + WS_WO), DM, DM, 64 * kb, 64 * nb, 64 * nb, 2, nullptr}; return J; }
    }, widx * NWAVES + F.wave, nwg * NWAVES);
    { constexpr int I_UP = (DM / 64) * (DFF / 64); const int nearly = UP_EARLY_PER_WAVE * nwg * NWAVES, up_early = nearly < I_UP ? nearly : I_UP;
      const float* w_up = F.w_up; const float* gml = F.g_mlp;
      tp_run(F, up_early, [=](int r) { const int nb = r % (DFF / 64), kb = r / (DFF / 64); TpJob J{w_up, (bf16*)(ws + WS_WUP), DM, DFF, 64 * kb, 64 * nb, 64 * nb, 0, gml}; return J; }, widx * NWAVES + F.wave, nwg * NWAVES); }
}
__device__ __forceinline__ void p5_convert_mlp_weights(Frame& F, int up_early) {
    constexpr int I_UP = (DM / 64) * (DFF / 64), I_DN = (DFF / 64) * (DM / 64);
    const float* w_up = F.w_up; const float* w_dn = F.w_down; const float* gml = F.g_mlp; unsigned char* ws = F.ws;
    const int n_up = I_UP - up_early;
    tp_run(F, n_up + I_DN, [=](int r) {
        TpJob J;
        if (r < n_up) { const int q = r + up_early, nb = q % (DFF / 64), kb = q / (DFF / 64); J = TpJob{w_up, (bf16*)(ws + WS_WUP), DM, DFF, 64 * kb, 64 * nb, 64 * nb, 0, gml}; return J; } r -= n_up;
        { const int nb = r % (DM / 64), kb = r / (DM / 64); J = TpJob{w_dn, (bf16*)(ws + WS_WDN), DFF, DM, 64 * kb, 64 * nb, 64 * nb, 0, nullptr}; return J; }
    }, F.vcu * NWAVES + F.wave, F.G * NWAVES);
}

using pg8::f32x2; using pg8::u32x4; using pg8::Unit;
__device__ __forceinline__ float sigmoidf_fast(float x) { return __builtin_amdgcn_rcpf(1.0f + __expf(-x)); }
template <int PART  > struct EpiInProj {
    static constexpr bool PERM = true;
    unsigned char* ws; const float* b_f; int pn_off; float scale;
    __device__ __forceinline__ void operator()(const f32x4 (&acc)[2][2][4][2], const Unit& u, int wr, int wc, int fr, int fq) const {
        int row0 = u.pm * 256 + wr * 64 + fr; asm volatile("" : "+v"(row0));
        const int c8 = wc * 32 + 8 * fq, pn = u.pn + pn_off; const float sc = scale;
        if (PART == 0 && pn < TILE_G0 && ((pn >> 3) == 0 || (pn >> 3) == 2 || (pn >> 3) == 3)) {
            unsigned char* base = ws + WS_E + (size_t)(pn >> 3) * ACT2K + (pn & 7) * 256 + c8;
#pragma unroll
            for (int ai = 0; ai < 2; ++ai)
#pragma unroll
                for (int m = 0; m < 4; ++m) { unsigned char* rowp = base + (size_t)(row0 + ai * 128 + m * 16) * DA;
#pragma unroll
                    for (int bj = 0; bj < 2; ++bj) { const f32x4 v0 = acc[ai][bj][m][0] * sc, v1 = acc[ai][bj][m][1] * sc;
                        int p0 = __builtin_amdgcn_cvt_pk_fp8_f32(v0[0], v0[1], 0, false); p0 = __builtin_amdgcn_cvt_pk_fp8_f32(v0[2], v0[3], p0, true);
                        int p1 = __builtin_amdgcn_cvt_pk_fp8_f32(v1[0], v1[1], 0, false); p1 = __builtin_amdgcn_cvt_pk_fp8_f32(v1[2], v1[3], p1, true);
                        pg8::u32x2 w2; w2.x = (unsigned)p0; w2.y = (unsigned)p1; *(pg8::u32x2*)(rowp + bj * 128) = w2; } }
        } else if (PART == 0 && pn < TILE_G0) {
            bf16* base = (bf16*)(ws + WS_E) + (size_t)(pn >> 3) * ((size_t)M * DA) + (pn & 7) * 256 + c8;
#pragma unroll
            for (int ai = 0; ai < 2; ++ai)
#pragma unroll
                for (int m = 0; m < 4; ++m) { bf16* rowp = base + (size_t)(row0 + ai * 128 + m * 16) * DA;
#pragma unroll
                    for (int bj = 0; bj < 2; ++bj) { const f32x4 v0 = acc[ai][bj][m][0] * sc, v1 = acc[ai][bj][m][1] * sc;
                        u32x4 w; w.x = pg8::cvt_pk_bf16(v0[0], v0[1]); w.y = pg8::cvt_pk_bf16(v0[2], v0[3]); w.z = pg8::cvt_pk_bf16(v1[0], v1[1]); w.w = pg8::cvt_pk_bf16(v1[2], v1[3]);
                        *(u32x4*)(rowp + bj * 128) = w; } }
        } else if (PART == 0) {
            const int t = pn - TILE_G0;
            unsigned char* base = ws + WS_GA + (size_t)(t >> 4) * ((size_t)M * DM) + (t & 15) * 256 + c8;
#pragma unroll
            for (int ai = 0; ai < 2; ++ai)
#pragma unroll
                for (int m = 0; m < 4; ++m) { unsigned char* rowp = base + (size_t)(row0 + ai * 128 + m * 16) * DM;
#pragma unroll
                    for (int bj = 0; bj < 2; ++bj) { const f32x4 v0 = acc[ai][bj][m][0] * sc, v1 = acc[ai][bj][m][1] * sc;
                        unsigned p0 = __builtin_amdgcn_cvt_pk_u8_f32(sigmoidf_fast(v0[0]) * 255.f, 0, 0u); p0 = __builtin_amdgcn_cvt_pk_u8_f32(sigmoidf_fast(v0[1]) * 255.f, 1, p0);
                        p0 = __builtin_amdgcn_cvt_pk_u8_f32(sigmoidf_fast(v0[2]) * 255.f, 2, p0); p0 = __builtin_amdgcn_cvt_pk_u8_f32(sigmoidf_fast(v0[3]) * 255.f, 3, p0);
                        unsigned p1 = __builtin_amdgcn_cvt_pk_u8_f32(sigmoidf_fast(v1[0]) * 255.f, 0, 0u); p1 = __builtin_amdgcn_cvt_pk_u8_f32(sigmoidf_fast(v1[1]) * 255.f, 1, p1);
                        p1 = __builtin_amdgcn_cvt_pk_u8_f32(sigmoidf_fast(v1[2]) * 255.f, 2, p1); p1 = __builtin_amdgcn_cvt_pk_u8_f32(sigmoidf_fast(v1[3]) * 255.f, 3, p1);
                        pg8::u32x2 w2; w2.x = p0; w2.y = p1; *(pg8::u32x2*)(rowp + bj * 128) = w2; } }
        } else if (PART == 1 && pn < TILE_SP) {
            bf16* base = (bf16*)(ws + WS_IQ);
#pragma unroll
            for (int ai = 0; ai < 2; ++ai)
#pragma unroll
                for (int m = 0; m < 4; ++m) { bf16* rowp = base + (size_t)(row0 + ai * 128 + m * 16) * 2048;
#pragma unroll
                    for (int bj = 0; bj < 2; ++bj) { const f32x4 v0 = acc[ai][bj][m][0], v1 = acc[ai][bj][m][1];
                        const int col = (pn - TILE_IQ0) * 256 + bj * 128 + c8, hh = col >> 6, d0 = col & 63;
                        u32x4 w; w.x = pk2h(v0[0], v0[1]); w.y = pk2h(v0[2], v0[3]); w.z = pk2h(v1[0], v1[1]); w.w = pk2h(v1[2], v1[3]);
                        *(u32x4*)(rowp + (d0 >> 4) * 512 + (((d0 >> 3) & 1) * 32 + hh) * 8) = w; } }
        } else if (PART == 1) {
#pragma unroll
            for (int ai = 0; ai < 2; ++ai)
#pragma unroll
                for (int m = 0; m < 4; ++m) { const size_t r = (size_t)(row0 + ai * 128 + m * 16); const f32x4 v0 = acc[ai][0][m][0], v1 = acc[ai][0][m][1];
                    if (c8 < 64) { u32x4 w; w.x = pk2h(v0[0], v0[1]); w.y = pk2h(v0[2], v0[3]); w.z = pk2h(v1[0], v1[1]); w.w = pk2h(v1[2], v1[3]); *(u32x4*)((bf16*)(ws + WS_IK) + (r >> 5) * 2048 + (c8 >> 4) * 512 + (((c8 >> 3) & 1) * 32 + (r & 31)) * 8) = w; }
                    else if (c8 < 96) { float* p = (float*)(ws + WS_IW) + r * 32 + (c8 - 64); *(f32x4*)p = v0 * IW_SCALE; *(f32x4*)(p + 4) = v1 * IW_SCALE; }
                    else if (c8 < 112) { float* p = (float*)(ws + WS_FL) + r * 16 + (c8 - 96); f32x4 o0, o1;
#pragma unroll
                        for (int j = 0; j < 4; ++j) { const float a = v0[j] + b_f[c8 - 96 + j], b = v1[j] + b_f[c8 - 96 + 4 + j];
                            o0[j] = fminf(a, 0.f) - log1pf(expf(-fabsf(a))); o1[j] = fminf(b, 0.f) - log1pf(expf(-fabsf(b))); }
                        *(f32x4*)p = o0; *(f32x4*)(p + 4) = o1; } }
        }
    }
};
template <bool SECOND> struct EpiGate {
    static constexpr bool PERM = true;
    const unsigned char* gate; bf16* T; bf16* out; float sc;
    __device__ __forceinline__ void operator()(const f32x4 (&acc)[2][2][4][2], const Unit& u, int wr, int wc, int fr, int fq) const {
        const int row0 = u.pm * 256 + wr * 64 + fr, col0 = u.pn * 256 + wc * 32 + 8 * fq;
#pragma unroll
        for (int ai = 0; ai < 2; ++ai)
#pragma unroll
            for (int m = 0; m < 4; ++m) { const size_t ro = (size_t)(row0 + ai * 128 + m * 16) * DM + col0;
#pragma unroll
                for (int bj = 0; bj < 2; ++bj) { const f32x4 v0 = acc[ai][bj][m][0], v1 = acc[ai][bj][m][1];
                    const pg8::u32x2 gv = *(const pg8::u32x2*)(gate + ro + bj * 128); const float c255 = sc * (1.0f / 255.0f);
                    float r[8] = { v0[0] * ((float)(gv.x & 0xffu) * c255), v0[1] * ((float)((gv.x >> 8) & 0xffu) * c255), v0[2] * ((float)((gv.x >> 16) & 0xffu) * c255), v0[3] * ((float)(gv.x >> 24) * c255),
                                   v1[0] * ((float)(gv.y & 0xffu) * c255), v1[1] * ((float)((gv.y >> 8) & 0xffu) * c255), v1[2] * ((float)((gv.y >> 16) & 0xffu) * c255), v1[3] * ((float)(gv.y >> 24) * c255) };
                    if constexpr (SECOND) {
                        const pg8::u32x2 tv = *(const pg8::u32x2*)((const unsigned char*)T + ro + bj * 128); constexpr float ct = 1.0f / 64.0f;
                        const f32x2 t0 = __builtin_amdgcn_cvt_pk_f32_fp8((int)tv.x, false), t1 = __builtin_amdgcn_cvt_pk_f32_fp8((int)tv.x, true), t2 = __builtin_amdgcn_cvt_pk_f32_fp8((int)tv.y, false), t3 = __builtin_amdgcn_cvt_pk_f32_fp8((int)tv.y, true);
                        r[0] += t0.x * ct; r[1] += t0.y * ct; r[2] += t1.x * ct; r[3] += t1.y * ct; r[4] += t2.x * ct; r[5] += t2.y * ct; r[6] += t3.x * ct; r[7] += t3.y * ct; }
                    if constexpr (SECOND) {
                        int p0 = __builtin_amdgcn_cvt_pk_fp8_f32(r[0] * 16.f, r[1] * 16.f, 0, false); p0 = __builtin_amdgcn_cvt_pk_fp8_f32(r[2] * 16.f, r[3] * 16.f, p0, true);
                        int p1 = __builtin_amdgcn_cvt_pk_fp8_f32(r[4] * 16.f, r[5] * 16.f, 0, false); p1 = __builtin_amdgcn_cvt_pk_fp8_f32(r[6] * 16.f, r[7] * 16.f, p1, true);
                        pg8::u32x2 w2; w2.x = (unsigned)p0; w2.y = (unsigned)p1; *(pg8::u32x2*)((unsigned char*)out + ro + bj * 128) = w2; }
                    else { int p0 = __builtin_amdgcn_cvt_pk_fp8_f32(r[0] * 64.f, r[1] * 64.f, 0, false); p0 = __builtin_amdgcn_cvt_pk_fp8_f32(r[2] * 64.f, r[3] * 64.f, p0, true);
                        int p1 = __builtin_amdgcn_cvt_pk_fp8_f32(r[4] * 64.f, r[5] * 64.f, 0, false); p1 = __builtin_amdgcn_cvt_pk_fp8_f32(r[6] * 64.f, r[7] * 64.f, p1, true);
                        pg8::u32x2 w2; w2.x = (unsigned)p0; w2.y = (unsigned)p1; *(pg8::u32x2*)((unsigned char*)out + ro + bj * 128) = w2; } }
                asm volatile("" ::: "memory"); }
    }
};
struct EpiResid {
    static constexpr bool PERM = true;
    const bf16* base; bf16* out;
    __device__ __forceinline__ void operator()(const f32x4 (&acc)[2][2][4][2], const Unit& u, int wr, int wc, int fr, int fq) const {
        const int row0 = u.pm * 256 + wr * 64 + fr, col0 = u.pn * 256 + wc * 32 + 8 * fq;
#pragma unroll
        for (int ai = 0; ai < 2; ++ai)
#pragma unroll
            for (int m = 0; m < 4; ++m) { const int row = row0 + ai * 128 + m * 16; const size_t ro = (size_t)row * DM + col0;
#pragma unroll
                for (int bj = 0; bj < 2; ++bj) { const u32x4 bv = *(const u32x4*)(base + ro + bj * 128); const f32x4 v0 = acc[ai][bj][m][0], v1 = acc[ai][bj][m][1];
                    u32x4 w; w.x = pg8::cvt_pk_bf16(v0[0] + pg8::bf_lo(bv.x), v0[1] + pg8::bf_hi(bv.x)); w.y = pg8::cvt_pk_bf16(v0[2] + pg8::bf_lo(bv.y), v0[3] + pg8::bf_hi(bv.y));
                    w.z = pg8::cvt_pk_bf16(v1[0] + pg8::bf_lo(bv.z), v1[1] + pg8::bf_hi(bv.z)); w.w = pg8::cvt_pk_bf16(v1[2] + pg8::bf_lo(bv.w), v1[3] + pg8::bf_hi(bv.w));
                    *(u32x4*)(out + ro + bj * 128) = w; }
                asm volatile("" ::: "memory"); }
    }
};
struct EpiResidNorm {
    static constexpr bool PERM = true;
    const float* base; bf16* xb; float* ss; float sc;
    __device__ __forceinline__ void operator()(const f32x4 (&acc)[2][2][4][2], const Unit& u, int wr, int wc, int fr, int fq) const {
        const int row0 = u.pm * 256 + wr * 64 + fr, col0 = u.pn * 256 + wc * 32 + 8 * fq;
#pragma unroll
        for (int ai = 0; ai < 2; ++ai)
#pragma unroll
            for (int m = 0; m < 4; ++m) { const int row = row0 + ai * 128 + m * 16; const size_t ro = (size_t)row * DM + col0; float q = 0.f;
#pragma unroll
                for (int bj = 0; bj < 2; ++bj) { const f32x4 b0 = *(const f32x4*)(base + ro + bj * 128), b1 = *(const f32x4*)(base + ro + bj * 128 + 4);
                    const f32x4 y0 = acc[ai][bj][m][0] * sc + b0, y1 = acc[ai][bj][m][1] * sc + b1;
                    u32x4 w; w.x = pg8::cvt_pk_bf16(y0[0], y0[1]); w.y = pg8::cvt_pk_bf16(y0[2], y0[3]); w.z = pg8::cvt_pk_bf16(y1[0], y1[1]); w.w = pg8::cvt_pk_bf16(y1[2], y1[3]);
                    *(u32x4*)(xb + ro + bj * 128) = w;
                    q += ((y0[0] * y0[0] + y0[1] * y0[1]) + (y0[2] * y0[2] + y0[3] * y0[3])) + ((y1[0] * y1[0] + y1[1] * y1[1]) + (y1[2] * y1[2] + y1[3] * y1[3])); }
                q += __shfl_xor(q, 16); q += __shfl_xor(q, 32);
                if (fq == 0) ss[(size_t)(4 * u.pn + wc) * M + row] = q;
                asm volatile("" ::: "memory"); }
    }
};
constexpr int RSTD_LDS_OFF = 135168;
struct EpiUp {
    static constexpr bool PERM = true;
    bf16* H; const float* ss; LAS float* rl; mutable int cpm;
    __device__ __forceinline__ void operator()(const f32x4 (&acc)[2][2][4][2], const Unit& u, int wr, int wc, int fr, int fq) const {
        if (u.pm != cpm) {
            __syncthreads();
            int t_ = threadIdx.x; asm volatile("" : "+v"(t_));
            const int prow = t_ >> 1, half = t_ & 1; const float* sp = ss + (size_t)(32 * half) * M + u.pm * 256 + prow; float q = 0.f;
#pragma unroll 8
            for (int i = 0; i < 32; ++i) q += sp[(size_t)i * M];
            q += __shfl_xor(q, 1);
            if (half == 0) rl[prow] = 1.0f / sqrtf(q * (1.f / DM) + EPS);
            __syncthreads();
            cpm = u.pm;
        }
        const int row0 = u.pm * 256 + wr * 64 + fr, col0 = u.pn * 256 + wc * 32 + 8 * fq;
#pragma unroll
        for (int ai = 0; ai < 2; ++ai)
#pragma unroll
            for (int m = 0; m < 4; ++m) { const int row = row0 + ai * 128 + m * 16; bf16* rowp = H + (size_t)row * DFF + col0; const float rs = rl[row & 255];
#pragma unroll
                for (int bj = 0; bj < 2; ++bj) { f32x4 v0 = acc[ai][bj][m][0] * rs, v1 = acc[ai][bj][m][1] * rs;
#pragma unroll
                    for (int j = 0; j < 4; ++j) { const float a = fmaxf(v0[j], 0.f), b = fmaxf(v1[j], 0.f); v0[j] = a * a; v1[j] = b * b; }
                    u32x4 w; w.x = pg8::cvt_pk_bf16(v0[0], v0[1]); w.y = pg8::cvt_pk_bf16(v0[2], v0[3]); w.z = pg8::cvt_pk_bf16(v1[0], v1[1]); w.w = pg8::cvt_pk_bf16(v1[2], v1[3]);
                    *(u32x4*)(rowp + bj * 128) = w; } }
    }
};

__device__ __forceinline__ float relu_bits(float x) { const int i = __builtin_bit_cast(int, x); return __builtin_bit_cast(float, i > 0 ? i : 0); }
constexpr int SC_PAD = 320;
constexpr size_t SC_PERB = (size_t)4096 * (NCHUNK * (NCHUNK + 1) / 2) + (size_t)64 * SC_PAD * NCHUNK;
__device__ __forceinline__ size_t score_off(int b, int c) { return (size_t)b * SC_PERB + (size_t)4096 * ((size_t)c * (c + 1) / 2) + (size_t)64 * SC_PAD * c; }
__device__ __forceinline__ void p2_scores(Frame& F) {
    const int gw = F.vcu * NWAVES + F.wave, NGW = F.G * NWAVES, lane = F.lane, r = lane & 31, hi = lane >> 5;
    if (gw < BATCH * NH) {
        const int b = gw / NH, h = gw % NH; const float* fl = (const float*)(F.ws + WS_FL) + (size_t)b * SEQ * 16 + h; float* cum = (float*)(F.ws + WS_CUM) + (size_t)(b * NH + h) * SEQ;
        float vals[128];
#pragma unroll
        for (int i = 0; i < 128; ++i) vals[i] = fl[(size_t)(128 * lane + i) * 16];
        float run = 0.f;
#pragma unroll
        for (int i = 0; i < 128; ++i) { run += vals[i]; vals[i] = run; }
        float incl = run;
#pragma unroll
        for (int o = 1; o < 64; o <<= 1) { const float t = __shfl_up(incl, o); if (lane >= o) incl += t; }
        const float off = incl - run;
#pragma unroll
        for (int i = 0; i < 128; i += 4) *(f32x4*)(cum + 128 * lane + i) = (f32x4){vals[i] + off, vals[i + 1] + off, vals[i + 2] + off, vals[i + 3] + off};
    }
    {
        const bf16* QBp = (const bf16*)(F.ws + WS_E) + (size_t)M * DA; const bf16* KBp = (const bf16*)(F.ws + WS_E) + 4 * (size_t)M * DA;
        float* nrm = (float*)(F.ws + WS_NORM);
        for (int it = gw; it < 2 * BATCH * NH * 128; it += NGW) {
            const int which = it & 1, tile = (it >> 1) & 127, bh = it >> 8, b = bh >> 4, h = bh & 15;
            const bf16* src = (which ? QBp : KBp) + ((size_t)b * SEQ + tile * 64 + lane) * DA + h * HD;
            float ss = 0.f;
#pragma unroll
            for (int i = 0; i < 16; ++i) { const u32x4 w = *(const u32x4*)(src + 8 * i);
                const float a0 = pg8::bf_lo(w.x), a1 = pg8::bf_hi(w.x), a2 = pg8::bf_lo(w.y), a3 = pg8::bf_hi(w.y), a4 = pg8::bf_lo(w.z), a5 = pg8::bf_hi(w.z), a6 = pg8::bf_lo(w.w), a7 = pg8::bf_hi(w.w);
                ss += (a0 * a0 + a1 * a1) + (a2 * a2 + a3 * a3) + (a4 * a4 + a5 * a5) + (a6 * a6 + a7 * a7); }
#pragma unroll
            for (int o = 1; o < 64; o <<= 1) ss = fmaxf(ss, __shfl_xor(ss, o));
            if (lane == 0) nrm[(size_t)(which * BATCH * NH + bh) * 128 + tile] = sqrtf(ss) * 1.001f;
        }
    }
}
__device__ __forceinline__ unsigned sortable(float f) { const unsigned u = __builtin_bit_cast(unsigned, f); return u ^ ((u >> 31) ? 0xFFFFFFFFu : 0x80000000u); }
__device__ __forceinline__ void select_regs(Frame& F, int row, unsigned (&v)[128]);
__device__ __forceinline__ void p2_index_select(Frame& F) {
    const int lane = F.lane, r = lane & 31, hi = lane >> 5, wave = F.wave;
    const bf16* IQ = (const bf16*)(F.ws + WS_IQ); const bf16* IK = (const bf16*)(F.ws + WS_IK); const float* IW = (const float*)(F.ws + WS_IW); float* SC = (float*)(F.ws + WS_SCORE);
    float* dummy = (float*)(F.ws + WS_MISC) + (size_t)(F.vcu * NWAVES + wave) * 64;
    LAS unsigned char* tl = F.lds + RING_OFF;
    for (int wu = blockIdx.x; wu < 2048; wu += F.G) {
        const int w = wu & 255, i8 = wu >> 8, p = w & 63, b = (w >> 6) & 1, c = (i8 & 1) ? 127 - p : p, qg = 4 * (w >> 7) + (i8 >> 1);
        const int limit = 64 * (c + 1), ntile = (limit + 127) >> 7;
        const size_t row = (size_t)b * SEQ + 64 * c + 8 * qg + wave;
        f32x4 wv[4];
        LAS unsigned char* asl = tl + 6 * 16384 + wave * 4096 + lane * 16;
        { f16x8 a_[4];
#pragma unroll
          for (int st = 0; st < 4; ++st) a_[st] = *(const f16x8*)(IQ + row * 2048 + 512 * st + lane * 8);
#pragma unroll
          for (int st = 0; st < 4; ++st) *(LAS f16x8*)(asl + st * 1024) = a_[st]; }
#pragma unroll
        for (int g4 = 0; g4 < 4; ++g4) wv[g4] = *(const f32x4*)(IW + row * 32 + 8 * g4 + 4 * hi);
        const char* ikb = (const char*)(IK + ((size_t)b * SEQ / 32) * 2048);
        unsigned v[128];
#pragma unroll
        for (int i = 0; i < 128; ++i) v[i] = 0u;
#define IDX_STAGE(t_, b_) do { const int tt_ = (t_) < ntile ? (t_) : ntile - 1; _Pragma("unroll") for (int i_ = 0; i_ < 2; ++i_) \
            __builtin_amdgcn_global_load_lds((const unsigned*)(ikb + (size_t)tt_ * 16384 + i_ * 8192 + wave * 1024 + lane * 16), (LAS unsigned*)(tl + (b_) * 16384 + i_ * 8192 + wave * 1024), 16, 0, 0); } while (0)
        IDX_STAGE(0, 0); IDX_STAGE(1, 1); IDX_STAGE(2, 2); IDX_STAGE(3, 3); IDX_STAGE(4, 4);
        asm volatile("s_waitcnt vmcnt(8)" ::: "memory"); asm volatile("s_waitcnt lgkmcnt(0)" ::: "memory"); __builtin_amdgcn_s_barrier(); asm volatile("" ::: "memory");
        for (int g6 = 0; 6 * g6 < ntile; ++g6) {
#pragma unroll
            for (int u = 0; u < 6; ++u) {
                const int t = 6 * g6 + u;
                if (t < ntile) {
                    IDX_STAGE(t + 5, (u + 5) % 6);
                    const LAS unsigned char* tb_ = tl + u * 16384 + lane * 16;
                    unsigned sk[2];
#pragma unroll
                    for (int h2 = 0; h2 < 2; ++h2) {
                        float a01[2];
#pragma unroll
                        for (int e = 0; e < 2; ++e) {
                            f32x16 acc = {};
#pragma unroll
                            for (int st = 0; st < 4; ++st) acc = __builtin_amdgcn_mfma_f32_32x32x16_f16(*(const LAS f16x8*)(asl + st * 1024), *(const LAS f16x8*)(tb_ + (2 * h2 + e) * 4096 + st * 1024), acc, 0, 0, 0);
                            f32x2 s0 = {0.f, 0.f};
#pragma unroll
                            for (int q = 0; q < 16; q += 2) { f32x2 w2; w2.x = wv[q >> 2][q & 3]; w2.y = wv[(q + 1) >> 2][(q + 1) & 3]; f32x2 r0; r0.x = relu_bits(acc[q]); r0.y = relu_bits(acc[q + 1]); s0 = w2 * r0 + s0; }
                            float a = s0.x + s0.y; a += __shfl_xor(a, 32); a01[e] = a;
                        }
                        const float sv = hi ? a01[1] : a01[0]; const int key = 128 * t + 64 * h2 + lane;
                        sk[h2] = (key < limit) ? sortable(sv) : 0u;
                    }
                    switch (g6) {
#define IDX_PARK(k_) case k_: if (12 * k_ + 2 * u + 1 < 128) { v[(12 * k_ + 2 * u) & 127] = sk[0]; v[(12 * k_ + 2 * u + 1) & 127] = sk[1]; } break;
                        IDX_PARK(0) IDX_PARK(1) IDX_PARK(2) IDX_PARK(3) IDX_PARK(4) IDX_PARK(5) IDX_PARK(6) IDX_PARK(7) IDX_PARK(8) IDX_PARK(9) IDX_PARK(10)
#undef IDX_PARK
                        default: break;
                    }
                    asm volatile("s_waitcnt vmcnt(8)" ::: "memory"); asm volatile("s_waitcnt lgkmcnt(0)" ::: "memory"); __builtin_amdgcn_s_barrier(); asm volatile("" ::: "memory");
                }
                __builtin_amdgcn_sched_barrier(0);
            }
        }
#undef IDX_STAGE
        asm volatile("s_waitcnt vmcnt(0)" ::: "memory"); __builtin_amdgcn_s_barrier(); asm volatile("" ::: "memory");
        select_regs(F, (int)row, v);
    }
}

__device__ __forceinline__ void select_regs(Frame& F, int row, unsigned (&v)[128]) {
    const int lane = F.lane;
    unsigned long long* MK = (unsigned long long*)(F.ws + WS_MASK);
        const int t = row % SEQ, c = t / 64, nsl = c + 1;
        unsigned long long* mrow = MK + (size_t)row * 128;
        if (nsl <= 4) { int l_ = lane; asm volatile("" : "+v"(l_)); mrow[l_] = (l_ < nsl) ? ~0ull : 0ull; mrow[l_ + 64] = 0ull; return; }
        unsigned q0 = 0u, q1 = 0u, q2 = 0u, q3 = 0u;
#pragma unroll
        for (int g = 0; g < 8; ++g) if (g * 16 < nsl) {
#pragma unroll
            for (int j = 0; j < 16; j += 4) { q0 = q0 > v[g * 16 + j] ? q0 : v[g * 16 + j]; q1 = q1 > v[g * 16 + j + 1] ? q1 : v[g * 16 + j + 1];
                q2 = q2 > v[g * 16 + j + 2] ? q2 : v[g * 16 + j + 2]; q3 = q3 > v[g * 16 + j + 3] ? q3 : v[g * 16 + j + 3]; } }
        unsigned vmax = q0 > q1 ? q0 : q1; { const unsigned t2 = q2 > q3 ? q2 : q3; vmax = vmax > t2 ? vmax : t2; }
        unsigned lmin = q0 < q1 ? q0 : q1; { const unsigned t2 = q2 < q3 ? q2 : q3; lmin = lmin < t2 ? lmin : t2; }
#pragma unroll
        for (int o = 1; o < 64; o <<= 1) { const unsigned ot = __shfl_xor(vmax, o); vmax = vmax > ot ? vmax : ot; const unsigned ol = __shfl_xor(lmin, o); lmin = lmin < ol ? lmin : ol; }
        const unsigned dx = vmax ^ lmin;
        const int topbit = dx ? 31 - __builtin_clz(dx) : -1;
        unsigned prefix = (topbit >= 31) ? 0u : (topbit < 0 ? vmax : (vmax & ~((2u << topbit) - 1u))); bool exact = false;
        for (int bit = topbit; bit >= 0; --bit) {
            const unsigned cand = prefix | (1u << bit); unsigned cnt = 0u;
#pragma unroll
            for (int g = 0; g < 8; ++g) if (g * 16 < nsl) { unsigned cd = cand; asm volatile("" : "+v"(cd));
#pragma unroll
                for (int j = 0; j < 16; ++j) cnt += (v[g * 16 + j] >= cd) ? 1u : 0u; }
#pragma unroll
            for (int o = 1; o < 64; o <<= 1) cnt += __shfl_xor(cnt, o);
            if (cnt >= (unsigned)TOPK) prefix = cand;
            if (cnt == (unsigned)TOPK) { exact = true; break; }
        }
        if (exact) {
#pragma unroll
            for (int sl = 0; sl < 128; ++sl) { const unsigned long long word = (sl < nsl) ? __ballot(v[sl] >= prefix) : 0ull;
                mrow[sl] = word;
                if ((sl & 7) == 7) __builtin_amdgcn_sched_barrier(0); }
            return;
        }
        unsigned cgt = 0u;
#pragma unroll
        for (int g = 0; g < 8; ++g) if (g * 16 < nsl) {
#pragma unroll
            for (int j = 0; j < 16; ++j) cgt += (v[g * 16 + j] > prefix) ? 1u : 0u; }
#pragma unroll
        for (int o = 1; o < 64; o <<= 1) cgt += __shfl_xor(cgt, o);
        unsigned need = (unsigned)TOPK - cgt, seen = 0u;
#pragma unroll
        for (int g = 0; g < 8; ++g) {
#pragma unroll
            for (int j = 0; j < 16; ++j) { const int sl = g * 16 + j;
                unsigned long long word = 0ull;
                if (sl < nsl) {
                    const bool gt = v[sl] > prefix, eq = v[sl] == prefix;
                    const unsigned long long eqm = __ballot(eq);
                    const unsigned before = seen + (unsigned)__popcll(eqm & ((1ull << lane) - 1ull));
                    word = __ballot(gt || (eq && before < need));
                    seen += (unsigned)__popcll(eqm);
                }
                if (lane == 0) mrow[sl] = word; }
        }
}

__device__ __forceinline__ int t5_bucket(int rel) {
    const int n = rel < 0 ? -rel : rel; int bkt;
    if (n < 8) bkt = n; else bkt = 8 + (n >= 15) + (n >= 27) + (n >= 50) + (n >= 91) + (n >= 166) + (n >= 305) + (n >= 559);
    return (rel > 0 ? 16 : 0) + bkt;
}

namespace att {
constexpr int NW = 8, QBLK = 32, KVBLK = 64, QB = NW * QBLK, D = 128, LD = 2048;
constexpr int SHM_V = KVBLK * D * 2, SHM_K = KVBLK * D * 2;
constexpr int OFF_WS = 2 * SHM_V + 2 * SHM_K, OFF_TB = OFF_WS + NW * 64 * 4, TB_N = 1088, OFF_DK = OFF_TB, LDS_NEED = OFF_DK + 132 * 64 * 4;
constexpr float SCALE = 0.08838834764831845f, INV_SCALE = 11.313708498984761f, THR = 8.f;
typedef short bf16x8 __attribute__((ext_vector_type(8)));
typedef short s16x4 __attribute__((ext_vector_type(4)));
typedef float f32x16 __attribute__((ext_vector_type(16)));
typedef unsigned u32x4 __attribute__((ext_vector_type(4)));
#define KSWZ(row, colB) ((row) * 256 + ((colB) ^ (((row) & 7) << 4)))
#define K8SWZ(row, ch) ((row) * 128 + ((((ch) ^ (((row) >> 1) & 7))) << 4))
#define SBAR() __builtin_amdgcn_sched_barrier(0)
__device__ __forceinline__ int v_st(int k, int c) { const int kk = (k & ~0xC) | ((k & 4) << 1) | ((k & 8) >> 1); return ((kk >> 3) * 4 + (c >> 5)) * 512 + ((kk & 7) * 32 + (c & 31)) * 2; }
__device__ __forceinline__ int v_rd_base(int lane) { return ((lane & 3) << 3) | (((lane >> 2) & 3) << 6) | (((lane >> 4) & 1) << 5) | (((lane >> 5) & 1) << 8); }
constexpr int v_rd_off(int d0, int ks, int half) { return d0 * 512 + ks * 4096 + half * 2048; }
__device__ __forceinline__ int crow(int r, int hi) { return (r & 3) + 8 * (r >> 2) + 4 * hi; }
__device__ __forceinline__ unsigned cvtpk(float lo, float hi) { return pg8::cvt_pk_bf16(lo, hi); }
__device__ __forceinline__ void mask_tile(f32x16& p0, f32x16& p1, int lr, int sdq) {
    const float NEG = -__builtin_inff();
#pragma unroll
    for (int r = 0; r < 16; ++r) { const int c = (r & 3) + 8 * (r >> 2); if (lr < c - sdq) p0[r] = NEG; if (lr < c + 32 - sdq) p1[r] = NEG; }
}
template <bool F8P = false>
__device__ __forceinline__ void partialSM(f32x16& p0, f32x16& p1, float& m_reg, float& mn, float& alpha) {
    float pmax = p0[0];
#pragma unroll
    for (int r = 1; r < 16; ++r) pmax = fmaxf(pmax, p0[r]);
#pragma unroll
    for (int r = 0; r < 16; ++r) pmax = fmaxf(pmax, p1[r]);
    { auto rr = __builtin_amdgcn_permlane32_swap(__float_as_uint(pmax), __float_as_uint(pmax), false, false); pmax = fmaxf(__uint_as_float(rr[0]), __uint_as_float(rr[1])); }
    constexpr float C2 = 1.4426950408889634f * SCALE;
    if (__builtin_expect(__all((pmax - m_reg) * SCALE <= (F8P ? 4.5f : THR)), 1)) { mn = m_reg; alpha = 1.f; }
    else { mn = fmaxf(m_reg, pmax); alpha = __builtin_amdgcn_exp2f((m_reg - mn) * C2); m_reg = mn; }
    const float mnL = -mn * C2 + (F8P ? 2.f : 0.f);
#pragma unroll
    for (int r = 0; r < 16; ++r) p0[r] = fmaf(p0[r], C2, mnL);
#pragma unroll
    for (int r = 0; r < 16; ++r) p1[r] = fmaf(p1[r], C2, mnL);
#pragma unroll
    for (int r = 0; r < 16; ++r) p0[r] = __builtin_amdgcn_exp2f(p0[r]);
}
__device__ __forceinline__ void finishSM(f32x16& p0, f32x16& p1, float alpha, float& l_reg, bf16x8& pa0, bf16x8& pa1, bf16x8& pa2, bf16x8& pa3) {
#pragma unroll
    for (int r = 0; r < 16; ++r) p1[r] = __builtin_amdgcn_exp2f(p1[r]);
    float ps = 0;
#pragma unroll
    for (int r = 0; r < 16; ++r) ps += p0[r];
#pragma unroll
    for (int r = 0; r < 16; ++r) ps += p1[r];
    { auto rr = __builtin_amdgcn_permlane32_swap(__float_as_uint(ps), __float_as_uint(ps), false, false); ps = __uint_as_float(rr[0]) + __uint_as_float(rr[1]); }
    l_reg = l_reg * alpha + ps;
#define PK4(P, B_, OUT) do { unsigned a0 = cvtpk(P[B_+0], P[B_+1]), a1 = cvtpk(P[B_+2], P[B_+3]); unsigned b0 = cvtpk(P[B_+4], P[B_+5]), b1 = cvtpk(P[B_+6], P[B_+7]); \
        auto r0 = __builtin_amdgcn_permlane32_swap(a0, b0, false, false); auto r1 = __builtin_amdgcn_permlane32_swap(a1, b1, false, false); \
        u32x4 w = {r0[0], r1[0], r0[1], r1[1]}; OUT = *reinterpret_cast<bf16x8*>(&w); } while (0)
    PK4(p0, 0, pa0); PK4(p0, 8, pa1); PK4(p1, 0, pa2); PK4(p1, 8, pa3);
#undef PK4
}
template <int KB>
__device__ __forceinline__ void qkt8(f32x16& p0, f32x16& p1, const char* K_lds, int r32, int hi, const bf16x8* qr) {
    typedef int i32x4_ __attribute__((ext_vector_type(4))); typedef int i32x8_ __attribute__((ext_vector_type(8)));
    const char* kt = K_lds + KB * SHM_K;
#pragma unroll
    for (int j = 0; j < 2; ++j) {
        const i32x8_ qv = __builtin_shufflevector(__builtin_bit_cast(i32x4_, qr[2 * j]), __builtin_bit_cast(i32x4_, qr[2 * j + 1]), 0, 1, 2, 3, 4, 5, 6, 7);
        const int c0 = 4 * j + 2 * hi;
        const i32x8_ k0v = __builtin_shufflevector(*(const i32x4_*)(kt + K8SWZ(r32, c0)), *(const i32x4_*)(kt + K8SWZ(r32, c0 + 1)), 0, 1, 2, 3, 4, 5, 6, 7);
        const i32x8_ k1v = __builtin_shufflevector(*(const i32x4_*)(kt + K8SWZ(32 + r32, c0)), *(const i32x4_*)(kt + K8SWZ(32 + r32, c0 + 1)), 0, 1, 2, 3, 4, 5, 6, 7);
        p0 = __builtin_amdgcn_mfma_scale_f32_32x32x64_f8f6f4(k0v, qv, p0, 0, 0, 0, 0x7f7f7f7f, 0, 0x7f7f7f7f);
        p1 = __builtin_amdgcn_mfma_scale_f32_32x32x64_f8f6f4(k1v, qv, p1, 0, 0, 0, 0x7f7f7f7f, 0, 0x7f7f7f7f);
    }
}
template <int KB>
__device__ __forceinline__ void qkt(f32x16& p0, f32x16& p1, const char* K_lds, int r32, int hi, const bf16x8* qr) {
    const char* kb[4];
#pragma unroll
    for (int dd = 0; dd < 4; ++dd) kb[dd] = K_lds + KB * SHM_K + KSWZ(r32, (dd * 16 + hi * 8) * 2);
#pragma unroll
    for (int d0 = 0; d0 < 8; ++d0) { const char* a = kb[d0 & 3] + (d0 >> 2) * 128;
        bf16x8 b0 = *reinterpret_cast<const bf16x8*>(a);
        bf16x8 b1 = *reinterpret_cast<const bf16x8*>(a + 32 * 256);
        p0 = __builtin_amdgcn_mfma_f32_32x32x16_bf16(b0, qr[d0], p0, 0, 0, 0);
        p1 = __builtin_amdgcn_mfma_f32_32x32x16_bf16(b1, qr[d0], p1, 0, 0, 0); }
}
template <int VB>
__device__ __forceinline__ void pv_tile(f32x16* o, int vb0, bf16x8 pa0, bf16x8 pa1, bf16x8 pa2, bf16x8 pa3) {
#define TRRD(dst, off) asm volatile("ds_read_b64_tr_b16 %0, %1 offset:%2" : "=&v"(dst) : "v"(vb0), "i"(off) : "memory")
#define PV_D0(d0) do { s16x4 l0, l1, l2, l3, h0, h1, h2, h3; constexpr int b_ = VB * SHM_V + v_rd_off(d0, 0, 0); \
        TRRD(l0, b_); TRRD(h0, b_ + 2048); TRRD(l1, b_ + 4096); TRRD(h1, b_ + 6144); TRRD(l2, b_ + 8192); TRRD(h2, b_ + 10240); TRRD(l3, b_ + 12288); TRRD(h3, b_ + 14336); \
        asm volatile("s_waitcnt lgkmcnt(0)" ::: "memory"); SBAR(); \
        o[d0] = __builtin_amdgcn_mfma_f32_32x32x16_bf16(pa0, (bf16x8){l0[0], l0[1], l0[2], l0[3], h0[0], h0[1], h0[2], h0[3]}, o[d0], 0, 0, 0); \
        o[d0] = __builtin_amdgcn_mfma_f32_32x32x16_bf16(pa1, (bf16x8){l1[0], l1[1], l1[2], l1[3], h1[0], h1[1], h1[2], h1[3]}, o[d0], 0, 0, 0); \
        o[d0] = __builtin_amdgcn_mfma_f32_32x32x16_bf16(pa2, (bf16x8){l2[0], l2[1], l2[2], l2[3], h2[0], h2[1], h2[2], h2[3]}, o[d0], 0, 0, 0); \
        o[d0] = __builtin_amdgcn_mfma_f32_32x32x16_bf16(pa3, (bf16x8){l3[0], l3[1], l3[2], l3[3], h3[0], h3[1], h3[2], h3[3]}, o[d0], 0, 0, 0); } while (0)
    PV_D0(0); PV_D0(1); PV_D0(2); PV_D0(3);
#undef PV_D0
#undef TRRD
}
#define V8SWZ(row, ch) ((row) * 128 + ((((ch) ^ ((row) & 7))) << 4))
__device__ __forceinline__ void finishSM8(f32x16& p0, f32x16& p1, float alpha, float& l_reg, bf16x8& pa0, bf16x8& pa1) {
#pragma unroll
    for (int r = 0; r < 16; ++r) p1[r] = __builtin_amdgcn_exp2f(p1[r]);
    float ps = 0;
#pragma unroll
    for (int r = 0; r < 16; ++r) ps += p0[r];
#pragma unroll
    for (int r = 0; r < 16; ++r) ps += p1[r];
    { auto rr = __builtin_amdgcn_permlane32_swap(__float_as_uint(ps), __float_as_uint(ps), false, false); ps = __uint_as_float(rr[0]) + __uint_as_float(rr[1]); }
    l_reg = l_reg * alpha + ps;
    unsigned w[8];
#pragma unroll
    for (int g = 0; g < 4; ++g) {
        int x = __builtin_amdgcn_cvt_pk_fp8_f32(p0[4 * g], p0[4 * g + 1], 0, false); x = __builtin_amdgcn_cvt_pk_fp8_f32(p0[4 * g + 2], p0[4 * g + 3], x, true);
        int y = __builtin_amdgcn_cvt_pk_fp8_f32(p1[4 * g], p1[4 * g + 1], 0, false); y = __builtin_amdgcn_cvt_pk_fp8_f32(p1[4 * g + 2], p1[4 * g + 3], y, true);
        auto rr = __builtin_amdgcn_permlane32_swap((unsigned)x, (unsigned)y, false, false);
        w[2 * g] = rr[0]; w[2 * g + 1] = rr[1]; }
    u32x4 a = {w[0], w[1], w[2], w[3]}, b = {w[4], w[5], w[6], w[7]};
    pa0 = *reinterpret_cast<bf16x8*>(&a); pa1 = *reinterpret_cast<bf16x8*>(&b);
}
template <int VB>
__device__ __forceinline__ void pv_tile8(f32x16* o, int vbase, int vb8, bf16x8 pa0, bf16x8 pa1) {
    typedef int i32x4_ __attribute__((ext_vector_type(4))); typedef int i32x8_ __attribute__((ext_vector_type(8))); typedef int i32x2_ __attribute__((ext_vector_type(2)));
    const i32x8_ pv = __builtin_shufflevector(__builtin_bit_cast(i32x4_, pa0), __builtin_bit_cast(i32x4_, pa1), 0, 1, 2, 3, 4, 5, 6, 7);
#pragma unroll
    for (int db = 0; db < 4; ++db) {
        const int ad = vbase + (vb8 ^ (db << 5));
        i32x2_ t0, t1, t2, t3;
        asm volatile("ds_read_b64_tr_b8 %0, %1 offset:%2" : "=&v"(t0) : "v"(ad), "i"(VB * SHM_V) : "memory");
        asm volatile("ds_read_b64_tr_b8 %0, %1 offset:%2" : "=&v"(t1) : "v"(ad), "i"(VB * SHM_V + 1024) : "memory");
        asm volatile("ds_read_b64_tr_b8 %0, %1 offset:%2" : "=&v"(t2) : "v"(ad), "i"(VB * SHM_V + 2048) : "memory");
        asm volatile("ds_read_b64_tr_b8 %0, %1 offset:%2" : "=&v"(t3) : "v"(ad), "i"(VB * SHM_V + 3072) : "memory");
        asm volatile("s_waitcnt lgkmcnt(0)" ::: "memory"); SBAR();
        const i32x8_ vv = {t0[0], t0[1], t1[0], t1[1], t2[0], t2[1], t3[0], t3[1]};
        o[db] = __builtin_amdgcn_mfma_scale_f32_32x32x64_f8f6f4(pv, vv, o[db], 0, 0, 0, 0x7f7f7f7f, 0, 0x7f7f7f7f);
    }
}
struct BlockRef { const bf16* Q; const bf16* K; const bf16* V; bf16* O; int P0, jlo; const unsigned long long* MK; const float* cum; };
struct Seam { bf16x8 qr[8]; bf16x8 st_v0, st_v1, st_k0, st_k1; };
#define AROW(p, k0, rr) ((p) + (size_t)((k0) + (rr)) * LD + sc)
#define VMW() asm volatile("s_waitcnt vmcnt(0)" ::: "memory")
#define VMWN(n) asm volatile("s_waitcnt vmcnt(%0)" :: "i"(n) : "memory")
#define SLOAD_H(Kp, Vp, k0) do { \
        if constexpr (MODE == 0) { S.st_v0 = *(const bf16x8*)((const char*)(Vp) + (size_t)((k0) + (tid >> 3)) * LD + (tid & 7) * 16); S.st_k0 = *(const bf16x8*)((const char*)(Kp) + (size_t)((k0) + (tid >> 3)) * LD + (tid & 7) * 16); } \
        else { S.st_v0 = *(const bf16x8*)AROW(Vp, k0, sr); S.st_v1 = *(const bf16x8*)AROW(Vp, k0, 32 + sr); S.st_k0 = *(const bf16x8*)AROW(Kp, k0, sr); S.st_k1 = *(const bf16x8*)AROW(Kp, k0, 32 + sr); } } while (0)
#define SWRITE_HK(bf) do { if constexpr (MODE == 0) { *(bf16x8*)(K_lds + (bf) * SHM_K + K8SWZ(tid >> 3, tid & 7)) = S.st_k0; } \
        else { *(bf16x8*)(K_lds + (bf) * SHM_K + kws) = S.st_k0; *(bf16x8*)(K_lds + (bf) * SHM_K + kws + 32 * 256) = S.st_k1; } } while (0)
#define QLOAD(Qp) do { if constexpr (MODE == 0) { const char* q8_ = (const char*)(Qp) + (size_t)(wid * QBLK + r32) * LD + 32 * hi; \
            S.qr[0] = *(const bf16x8*)(q8_); S.qr[1] = *(const bf16x8*)(q8_ + 16); S.qr[2] = *(const bf16x8*)(q8_ + 64); S.qr[3] = *(const bf16x8*)(q8_ + 80); } \
        else { _Pragma("unroll") for (int d0 = 0; d0 < 8; ++d0) S.qr[d0] = *(const bf16x8*)((Qp) + (size_t)(wid * QBLK + r32) * LD + d0 * 16 + hi * 8); } } while (0)
#define SWRITE_HV(bf) do { if constexpr (MODE == 0) { *(bf16x8*)(V_lds + (bf) * SHM_V + V8SWZ(tid >> 3, tid & 7)) = S.st_v0; } \
        else { *(bf16x8*)(V_lds + (bf) * SHM_V + vst0) = S.st_v0; *(bf16x8*)(V_lds + (bf) * SHM_V + vst1) = S.st_v1; } } while (0)
template <int MODE>
__device__ __forceinline__ void attn_prime(const BlockRef& cur, char* lds, Seam& S) {
    int tid_ = threadIdx.x; asm volatile("" : "+v"(tid_)); const int tid = tid_, wid = __builtin_amdgcn_readfirstlane(tid >> 6), lane = tid & 63, r32 = lane & 31, hi = lane >> 5;
    const int sr = tid >> 4, sc = (tid & 15) * 8, kws = KSWZ(sr, sc * 2); char* K_lds = lds + 2 * SHM_V;
    const int kb0 = cur.jlo * KVBLK;
    QLOAD(cur.Q);
    SLOAD_H(cur.K, cur.V, kb0); VMW(); SWRITE_HK(0);
    __syncthreads();
}
template <int MODE>
__device__ __forceinline__ void attn_block(const BlockRef& cur, const BlockRef& nxt, const float* bias_h, char* lds, Seam& S) {
    int tid_ = threadIdx.x; asm volatile("" : "+v"(tid_)); const int tid = tid_, wid = __builtin_amdgcn_readfirstlane(tid >> 6), lane = tid & 63, r32 = lane & 31, hi = lane >> 5;
    const int j_lo = cur.jlo, j_hi = cur.P0 / KVBLK + 4, NT = j_hi - j_lo;
    const int kbn = nxt.jlo * KVBLK;
    const int qlo = cur.P0 + wid * QBLK; int lr = r32 - 4 * hi; asm volatile("" : "+v"(lr));
    char* V_lds = lds; char* K_lds = lds + 2 * SHM_V;
    float* ws = (float*)(lds + OFF_WS) + wid * 64; float* li_l = ws, * al_l = ws + 32;
    float* tb = (float*)(lds + OFF_TB); float* dkb = (float*)(lds + OFF_DK);
    float m_reg = -1e30f, l_reg = 0; f32x16 o[4] = {};
    const int sr = tid >> 4, sc = (tid & 15) * 8, vst0 = v_st(sr, sc), vst1 = v_st(32 + sr, sc), kws = KSWZ(sr, sc * 2);
    const int vb0 = (int)(uintptr_t)V_lds + v_rd_base(lane);
    const int vb8 = (32 * hi + ((lane & 15) >> 1)) * 128 + (((((lane >> 4) & 1)) ^ ((lane & 15) >> 1)) << 4) + 8 * (lane & 1);
#define FIN(P0_, P1_, al_) do { if constexpr (MODE == 0) finishSM8(P0_, P1_, al_, l_reg, pa0, pa1); else finishSM(P0_, P1_, al_, l_reg, pa0, pa1, pa2, pa3); } while (0)
#define PVT(VB_) do { if constexpr (MODE == 0) pv_tile8<VB_>(o, (int)(uintptr_t)V_lds, vb8, pa0, pa1); else pv_tile<VB_>(o, vb0, pa0, pa1, pa2, pa3); } while (0)
#define PSM(P0_, P1_, mn_, al_) partialSM<MODE == 0>(P0_, P1_, m_reg, mn_, al_)
    const bf16* Kh = cur.K; const bf16* Vh = cur.V;
    const float NEG = -__builtin_inff();
    const unsigned long long* mrow = nullptr; unsigned long long mw_cur = 0ull, mw_nxt = 0ull; float c15 = 0.f;
    float cref = 0.f;
    if constexpr (MODE == 0) {
        mrow = cur.MK + (size_t)(wid * QBLK + r32) * 128;
        for (int i = tid; i < TB_N; i += NW * 64) tb[i] = bias_h[t5_bucket(i - 1023) * NH] * INV_SCALE;
        c15 = bias_h[15 * NH] * INV_SCALE;
        mw_cur = mrow[j_lo];
    } else {
        cref = cur.cum[cur.P0];
        for (int i = tid; i < NT * KVBLK; i += NW * 64) dkb[i] = -(cur.cum[j_lo * KVBLK + i] - cref) * INV_SCALE;
    }
#define RESC(a) do { if (__any((a) < 1.f)) { if (hi == 0) al_l[r32] = (a); asm volatile("s_waitcnt lgkmcnt(0)" ::: "memory"); \
                     for (int d_ = 0; d_ < 4; ++d_) for (int r = 0; r < 16; ++r) o[d_][r] *= al_l[crow(r, hi)]; } } while (0)
#define KBASE(t) ((j_lo + (t)) * KVBLK)
#define PINIT(P0_, P1_, t, DB) do { \
        if constexpr (MODE == 0) { const unsigned lo_ = (unsigned)mw_cur >> (4 * hi), hi_ = (unsigned)(mw_cur >> 32) >> (4 * hi); const int kb_ = KBASE(t); \
            if (kb_ + 63 - qlo <= -559) { _Pragma("unroll") for (int r = 0; r < 16; ++r) { const int c = (r & 3) + 8 * (r >> 2); P0_[r] = ((lo_ >> c) & 1u) ? c15 : NEG; P1_[r] = ((hi_ >> c) & 1u) ? c15 : NEG; } } \
            else { const float* tq_ = tb + (kb_ - (qlo + r32) + 4 * hi + 1023); \
                _Pragma("unroll") for (int r = 0; r < 16; ++r) { const int c = (r & 3) + 8 * (r >> 2); const float b0_ = tq_[c], b1_ = tq_[c + 32]; P0_[r] = ((lo_ >> c) & 1u) ? b0_ : NEG; P1_[r] = ((hi_ >> c) & 1u) ? b1_ : NEG; } } \
            if ((t) + 1 < NT) mw_nxt = mrow[j_lo + (t) + 1]; \
        } else { const float* dq_ = dkb + (t) * 64 + 4 * hi; \
            _Pragma("unroll") for (int g = 0; g < 4; ++g) { const f32x4 a_ = *(const f32x4*)(dq_ + 8 * g), b_ = *(const f32x4*)(dq_ + 32 + 8 * g); \
                P0_[4 * g] = a_[0]; P0_[4 * g + 1] = a_[1]; P0_[4 * g + 2] = a_[2]; P0_[4 * g + 3] = a_[3]; P1_[4 * g] = b_[0]; P1_[4 * g + 1] = b_[1]; P1_[4 * g + 2] = b_[2]; P1_[4 * g + 3] = b_[3]; } } \
    } while (0)
#define PNEXT() do { if constexpr (MODE == 0) mw_cur = mw_nxt; } while (0)
#define MASKT(P0_, P1_, t) do { if constexpr (MODE == 1) { const int kb_ = KBASE(t); if (kb_ + KVBLK - 1 > qlo) mask_tile(P0_, P1_, lr, qlo - kb_); } } while (0)
#define DKLOAD(t) do { } while (0)
#define DKWRITE(bf) do { } while (0)
#define QKT(KB_, P0_, P1_) do { if constexpr (MODE == 0) qkt8<KB_>(P0_, P1_, K_lds, r32, hi, S.qr); else qkt<KB_>(P0_, P1_, K_lds, r32, hi, S.qr); } while (0)
    constexpr int NQL = (MODE == 0) ? 4 : 8;
#define SEAM_K0() do { VMWN(NQL); SWRITE_HK(0); SBAR(); } while (0)
    f32x16 pA0, pA1, pB0, pB1; float mnA, mnB, alA, alB; bf16x8 pa0, pa1, pa2, pa3;
    SWRITE_HV(0); SBAR();
    __syncthreads();
    if (NT > 1) { SLOAD_H(Kh, Vh, KBASE(1)); DKLOAD(1); }
    SBAR(); PINIT(pA0, pA1, 0, 0); QKT(0, pA0, pA1); PNEXT();
    MASKT(pA0, pA1, 0); PSM(pA0, pA1, mnA, alA);
    if (NT > 1) { VMW(); SWRITE_HV(1); SWRITE_HK(1); DKWRITE(1); }
    __syncthreads();
#define HALF_STEP(PX0, PX1, mnX, alX, PY0, PY1, alY, t, KB, VB, SB) do { \
        SBAR(); PINIT(PX0, PX1, t, KB); QKT(KB, PX0, PX1); \
        FIN(PY0, PY1, alY); SBAR(); \
        if ((t) + 1 < NT) { SLOAD_H(Kh, Vh, KBASE((t) + 1)); DKLOAD((t) + 1); SBAR(); } \
        PVT(VB); MASKT(PX0, PX1, (t)); PSM(PX0, PX1, mnX, alX); \
        __syncthreads(); \
        if ((t) + 1 < NT) { VMW(); SWRITE_HV(SB); SWRITE_HK(SB); DKWRITE(SB); } \
        PNEXT(); RESC(alX); __syncthreads(); } while (0)
    for (int t = 1; t + 1 < NT; t += 2) {
        HALF_STEP(pB0, pB1, mnB, alB, pA0, pA1, alA, t, 1, 0, 0);
        HALF_STEP(pA0, pA1, mnA, alA, pB0, pB1, alB, t + 1, 0, 1, 1);
    }
    const bool even = (NT & 1) == 0;
    if (even) { SBAR(); PINIT(pB0, pB1, NT - 1, 1); QKT(1, pB0, pB1); PNEXT(); SBAR(); }
    VMW();
    SLOAD_H(nxt.K, nxt.V, kbn); SBAR();
    { int qo_ = (wid * QBLK + r32) * LD; asm volatile("" : "+v"(qo_));
      if constexpr (MODE == 0) { const char* q8_ = (const char*)nxt.Q + qo_ + 32 * hi; S.qr[0] = *(const bf16x8*)(q8_); S.qr[1] = *(const bf16x8*)(q8_ + 16); S.qr[2] = *(const bf16x8*)(q8_ + 64); S.qr[3] = *(const bf16x8*)(q8_ + 80); }
      else {
#pragma unroll
        for (int d0 = 0; d0 < 8; ++d0) S.qr[d0] = *(const bf16x8*)(nxt.Q + qo_ + hi * 8 + d0 * 16); } }
    SBAR();
    FIN(pA0, pA1, alA); SBAR();
    PVT(0);
    if (even) { MASKT(pB0, pB1, NT - 1); PSM(pB0, pB1, mnB, alB); __syncthreads(); RESC(alB);
        FIN(pB0, pB1, alB); SBAR(); PVT(1); }
    SBAR(); SEAM_K0();
    if (hi == 0) li_l[r32] = l_reg; asm volatile("s_waitcnt lgkmcnt(0)" ::: "memory");
    float rli[16];
#pragma unroll
    for (int r = 0; r < 16; ++r) rli[r] = __builtin_amdgcn_rcpf(li_l[crow(r, hi)]);
    int oo_ = (wid * QBLK + 4 * hi) * LD + r32; asm volatile("" : "+v"(oo_));
    unsigned char* Ow = (unsigned char*)cur.O + oo_;
#pragma unroll
    for (int r = 0; r < 16; ++r) { const int orow = (r & 3) + 8 * (r >> 2);
#pragma unroll
        for (int d0 = 0; d0 < 4; ++d0) { const float v = o[d0][r] * (rli[r] * 16.f); const float vn = __shfl_xor(v, 1);
            if ((r32 & 1) == 0) *(unsigned short*)(Ow + orow * LD + d0 * 32) = (unsigned short)__builtin_amdgcn_cvt_pk_fp8_f32(v, vn, 0, false); } }
    __syncthreads();
#undef RESC
#undef KBASE
#undef PINIT
#undef PNEXT
#undef MASKT
#undef DKLOAD
#undef DKWRITE
#undef SEAM_K0
#undef HALF_STEP
#undef QKT
#undef FIN
#undef PVT
#undef PSM
}
#undef AROW
#undef VMW
#undef VMWN
#undef SLOAD_H
#undef SWRITE_HK
#undef SWRITE_HV
#undef KSWZ
#undef K8SWZ
#undef V8SWZ
#undef QLOAD
#undef SBAR
}

constexpr float FOX_SKIP = -40.0f;
__device__ __forceinline__ int fox_jlo(Frame& F, int bh, int qb) {
    const float* kn = (const float*)(F.ws + WS_NORM) + (size_t)bh * 128; const float* qn = (const float*)(F.ws + WS_NORM) + (size_t)(BATCH * NH + bh) * 128;
    const float* cum = (const float*)(F.ws + WS_CUM) + (size_t)bh * SEQ;
    const int j0 = 4 * qb, lane = F.lane;
    const float Qm = fmaxf(fmaxf(qn[j0], qn[j0 + 1]), fmaxf(qn[j0 + 2], qn[j0 + 3])), Kd = fmaxf(fmaxf(kn[j0], kn[j0 + 1]), fmaxf(kn[j0 + 2], kn[j0 + 3]));
    const float c0 = cum[256 * qb];
    bool keep0 = true, keep1 = true;
    if (lane < j0) keep0 = !(Qm * (kn[lane] + Kd) * ATT_SCALE + (c0 - cum[64 * lane + 63]) < FOX_SKIP);
    if (64 + lane < j0) keep1 = !(Qm * (kn[64 + lane] + Kd) * ATT_SCALE + (c0 - cum[64 * (64 + lane) + 63]) < FOX_SKIP);
    const unsigned long long m0 = __ballot(keep0), m1 = __ballot(keep1);
    const int jl = m0 ? __builtin_ctzll(m0) : 64 + __builtin_ctzll(m1);
    return __builtin_amdgcn_readfirstlane(jl);
}
template <int MODE>
__device__ __forceinline__ att::BlockRef p4_ref(Frame& F, int L, int jlo) {
    const int xcd = L & 7, k = (L >> 3) & 31, i = L >> 8, bh = 4 * xcd + ((MODE == 1) ? (((k >> 3) + i) & 3) : (k >> 3)), p = k & 7, b = bh >> 4, h = bh & 15;
    const int qb = (i == 0) ? p : (i == 1) ? 31 - p : (i == 2) ? 8 + p : 23 - p;
    bf16* E = (bf16*)(F.ws + WS_E); const size_t TS = (size_t)M * DA;
    att::BlockRef r; const size_t rowq = (size_t)b * SEQ + (size_t)qb * 256, rowk = (size_t)b * SEQ;
    if constexpr (MODE == 0) { r.Q = (const bf16*)(F.ws + WS_E + rowq * DA + h * HD); r.O = (bf16*)(F.ws + WS_Y8A + rowq * DA + h * HD); r.K = (const bf16*)(F.ws + WS_E + 2 * ACT2K + rowk * DA + h * HD); r.V = (const bf16*)(F.ws + WS_E + 3 * ACT2K + rowk * DA + h * HD); }
    else { r.Q = E + TS + rowq * DA + h * HD; r.O = (bf16*)(F.ws + WS_Y8B + rowq * DA + h * HD); r.K = E + 4 * TS + rowk * DA + h * HD; r.V = E + 5 * TS + rowk * DA + h * HD; }
    r.P0 = qb * 256; r.jlo = jlo;
    r.MK = (const unsigned long long*)(F.ws + WS_MASK) + rowq * 128; r.cum = (const float*)(F.ws + WS_CUM) + (size_t)(b * NH + h) * SEQ;
    return r;
}
__device__ __forceinline__ void p4_decode(int L, int mode, int& bh, int& qb) {
    const int xcd = L & 7, k = (L >> 3) & 31, i = L >> 8, p = k & 7;
    bh = 4 * xcd + (mode ? (((k >> 3) + i) & 3) : (k >> 3)); qb = (i == 0) ? p : (i == 1) ? 31 - p : (i == 2) ? 8 + p : 23 - p;
}
template <int MODE>
__device__ __forceinline__ void p4_attention_branch(Frame& F, char* lds) {
    const int G = F.G; int L = blockIdx.x; if (L >= 1024) return;
    int jl[4] = {0, 0, 0, 0};
    if constexpr (MODE == 1) {
#pragma unroll
        for (int i = 0; i < 4; ++i) { const int Li = L + i * G; if (Li < 1024) { int bh, qb; p4_decode(Li, 1, bh, qb); jl[i] = fox_jlo(F, bh, qb); } }
    }
    int bi = 0;
    att::BlockRef cur = p4_ref<MODE>(F, L, jl[0]); att::Seam S;
    att::attn_prime<MODE>(cur, lds, S);
    for (;;) {
        const bool last = L + G >= 1024 || bi >= 3; const int Ln = last ? L : L + G;
        const int jn = (bi == 0) ? jl[1] : (bi == 1) ? jl[2] : jl[3];
        const att::BlockRef nxt = last ? cur : p4_ref<MODE>(F, Ln, jn);
        int bh, qb; p4_decode(L, MODE, bh, qb);
        att::attn_block<MODE>(cur, nxt, F.rel_bias + (bh & 15), lds, S);
        if (last) break;
        cur = nxt; L = Ln; ++bi;
    }
}

template <bool TO_BF16>
__device__ __forceinline__ void rmsnorm_rows(Frame& F, const float* src, const float* g, float* dstf, bf16* dstb) {
    const int gw = F.vcu * NWAVES + F.wave, NGW = F.G * NWAVES;
    for (int m = gw; m < M; m += NGW) {
        const GAS f32x4* xr = (const GAS f32x4*)(src + (size_t)m * DM) + F.lane; const GAS f32x4* gr = (const GAS f32x4*)g + F.lane;
        f32x4 v[16]; float s = 0.f;
#pragma unroll
        for (int j = 0; j < 16; ++j) { v[j] = xr[64 * j]; s += (v[j].x * v[j].x + v[j].y * v[j].y) + (v[j].z * v[j].z + v[j].w * v[j].w); }
        const float rstd = 1.0f / sqrtf(wave_sum(s) * (1.f / DM) + EPS);
        if constexpr (TO_BF16) { GAS unsigned long long* o8 = (GAS unsigned long long*)(dstb + (size_t)m * DM) + F.lane;
#pragma unroll
            for (int j = 0; j < 16; ++j) { const f32x4 gg = gr[64 * j];
                o8[64 * j] = (unsigned long long)pk2bf(v[j].x * rstd * gg.x, v[j].y * rstd * gg.y) | ((unsigned long long)pk2bf(v[j].z * rstd * gg.z, v[j].w * rstd * gg.w) << 32); } }
        else { GAS f32x4* o = (GAS f32x4*)(dstf + (size_t)m * DM) + F.lane;
#pragma unroll
            for (int j = 0; j < 16; ++j) { const f32x4 gg = gr[64 * j]; o[64 * j] = v[j] * rstd * gg; } }
    }
}

__device__ __forceinline__ void final_norm_rows(Frame& F, const bf16* src, const float* g, float* dst) {
    const int gw = F.vcu * NWAVES + F.wave, NGW = F.G * NWAVES;
    for (int m = gw; m < M; m += NGW) {
        const GAS v4u* xr = (const GAS v4u*)(src + (size_t)m * DM) + F.lane; const GAS f32x4* gr = (const GAS f32x4*)g + 2 * F.lane;
        v4u v[8]; float s = 0.f;
#pragma unroll
        for (int j = 0; j < 8; ++j) v[j] = xr[64 * j];
#pragma unroll
        for (int j = 0; j < 8; ++j) { const float a0 = pg8::bf_lo(v[j].x), a1 = pg8::bf_hi(v[j].x), a2 = pg8::bf_lo(v[j].y), a3 = pg8::bf_hi(v[j].y), a4 = pg8::bf_lo(v[j].z), a5 = pg8::bf_hi(v[j].z), a6 = pg8::bf_lo(v[j].w), a7 = pg8::bf_hi(v[j].w);
            s += ((a0 * a0 + a1 * a1) + (a2 * a2 + a3 * a3)) + ((a4 * a4 + a5 * a5) + (a6 * a6 + a7 * a7)); }
        const float rstd = 1.0f / sqrtf(wave_sum(s) * (1.f / DM) + EPS);
        GAS f32x4* o = (GAS f32x4*)(dst + (size_t)m * DM) + 2 * F.lane;
#pragma unroll
        for (int j = 0; j < 8; ++j) { const f32x4 g0 = gr[128 * j], g1 = gr[128 * j + 1];
            f32x4 y0 = {pg8::bf_lo(v[j].x), pg8::bf_hi(v[j].x), pg8::bf_lo(v[j].y), pg8::bf_hi(v[j].y)}, y1 = {pg8::bf_lo(v[j].z), pg8::bf_hi(v[j].z), pg8::bf_lo(v[j].w), pg8::bf_hi(v[j].w)};
            o[128 * j] = y0 * rstd * g0; o[128 * j + 1] = y1 * rstd * g1; }
    }
}

constexpr int N_PHASES = 12;
struct Args { const float* in[12]; float* out; unsigned char* ws; int ph_lo, ph_hi, li, pad; };
__global__ void __launch_bounds__(NWAVES * 64, 2) fwd(Args args) {
    extern __shared__ __attribute__((aligned(16))) unsigned char lds[];
    Frame F;
    F.lds = (LAS unsigned char*)lds;
    F.MISC = (volatile LAS unsigned*)(F.lds + MISC_OFF);
    F.tid = threadIdx.x; F.lane = F.tid & 63; F.wave = __builtin_amdgcn_readfirstlane(F.tid >> 6);
    F.G = gridDim.x; { const int bx = blockIdx.x; F.vcu = (F.G % 8 == 0) ? (bx % 8) * (F.G / 8) + bx / 8 : bx; }
    F.ws = args.ws; F.ctl = (gu32*)(args.ws + WS_CTL);
    F.x = args.in[0]; F.w_in = args.in[1]; F.b_f = args.in[2]; F.w_out_a = args.in[3]; F.w_out_b = args.in[4]; F.w_o = args.in[5]; F.w_up = args.in[6]; F.w_down = args.in[7];
    F.g_mix = args.in[8]; F.g_mlp = args.in[9]; F.g_final = args.in[10]; F.rel_bias = args.in[11]; F.out = args.out;
    for (int u = F.tid; u < (LDS_BYTES - LDSCTL_OFF) / 4; u += NWAVES * 64) ((LAS unsigned*)(F.lds + LDSCTL_OFF))[u] = 0u;
    __syncthreads();
    XcdBarrier bar = xcd_barrier_post((unsigned*)(F.ctl + CW_BAR) + args.li * XCD_BAR_WORDS, F.MISC + 8);
    const int lo = args.ph_lo, hi = args.ph_hi;
#define IN(k) (lo <= (k) && (k) < hi)
#define SEAM(k) do { if (IN(k) && IN((k) + 1)) xcd_barrier(bar); } while (0)
#define LANES() do { int t_ = threadIdx.x; asm volatile("" : "+v"(t_)); F.tid = t_; F.lane = t_ & 63; } while (0)
    unsigned char* ws = args.ws;
    if (IN(0)) { LANES(); p0_prologue(F); } SEAM(0);
    if (IN(1)) { LANES();
        { pg8::Gemm g{(const bf16*)(ws + WS_XN8), (const bf16*)(ws + WS_WIN8), M, DST_IQ, DM / 2}; pg8::StaticOrder S; S.init(M, DST_IQ, F.G, (int)blockIdx.x);
          EpiInProj<0> E{ws, F.b_f, 0, 1.0f / 64.0f};
          pg8::gemm_phase<EpiInProj<0>, pg8::StaticOrder, 2>(F.lds + RING_OFF, g, S, E); }
        pg8::Gemm g{(const bf16*)(ws + WS_XN), (const bf16*)(ws + WS_WINH), M, NPAD - DST_IQ, DM}; pg8::StaticOrder S; S.init(M, NPAD - DST_IQ, F.G, (int)blockIdx.x);
        EpiInProj<1> E{ws, F.b_f, TILE_IQ0, 1.0f};
        pg8::gemm_phase<EpiInProj<1>, pg8::StaticOrder, 1>(F.lds + RING_OFF, g, S, E);
        { const int nunits = (M / 256) * (NPAD / 256), nlast = nunits % F.G, nidle = F.G - nlast;
          if (nlast == 0) p1_convert_small_weights(F, (int)blockIdx.x, F.G);
          else if ((int)blockIdx.x >= nlast) p1_convert_small_weights(F, (int)blockIdx.x - nlast, nidle); }
    } SEAM(1);
    if (IN(2)) { LANES(); p2_scores(F); __syncthreads(); p2_index_select(F); } SEAM(2);
    if (IN(4)) { LANES(); p4_attention_branch<0>(F, (char*)lds + RING_OFF); __syncthreads(); p4_attention_branch<1>(F, (char*)lds + RING_OFF); } SEAM(4);
    if (IN(5)) { LANES();
        { const int nunits = (M / 256) * (NPAD / 256), nlast = nunits % F.G, nidle = (nlast == 0) ? F.G : F.G - nlast; constexpr int I_UP = (DM / 64) * (DFF / 64);
          const int nearly = UP_EARLY_PER_WAVE * nidle * NWAVES; p5_convert_mlp_weights(F, nearly < I_UP ? nearly : I_UP); } __syncthreads();
        pg8::Gemm g{(const bf16*)(ws + WS_Y8A), (const bf16*)(ws + WS_WOA), M, DM, DA / 2}; pg8::StaticOrder S; S.init(M, DM, F.G, (int)blockIdx.x);
        EpiGate<false> E{ws + WS_GA, nullptr, (bf16*)(ws + WS_T), 1.0f / 1024.0f};
        pg8::gemm_phase<EpiGate<false>, pg8::StaticOrder, 2>(F.lds + RING_OFF, g, S, E);
    }
    if (IN(6)) { LANES();
        pg8::Gemm g{(const bf16*)(ws + WS_Y8B), (const bf16*)(ws + WS_WOB), M, DM, DA / 2}; pg8::StaticOrder S; S.init(M, DM, F.G, (int)blockIdx.x);
        EpiGate<true> E{ws + WS_GB, (bf16*)(ws + WS_T), (bf16*)(ws + WS_MERGED), 1.0f / 1024.0f};
        pg8::gemm_phase<EpiGate<true>, pg8::StaticOrder, 2>(F.lds + RING_OFF, g, S, E);
    } SEAM(6);
    if (IN(7)) { LANES();
        pg8::Gemm g{(const bf16*)(ws + WS_MERGED), (const bf16*)(ws + WS_WO), M, DM, DM / 2}; pg8::StaticOrder S; S.init(M, DM, F.G, (int)blockIdx.x);
        EpiResidNorm E{F.x, (bf16*)(ws + WS_X1B), (float*)(ws + WS_SSP), 1.0f / 1024.0f};
        pg8::gemm_phase<EpiResidNorm, pg8::StaticOrder, 2>(F.lds + RING_OFF, g, S, E);
    } SEAM(7);
    if (IN(9)) { LANES();
        pg8::Gemm g{(const bf16*)(ws + WS_X1B), (const bf16*)(ws + WS_WUP), M, DFF, DM}; pg8::StaticOrder S; S.init(M, DFF, F.G, (int)blockIdx.x);
        EpiUp E{(bf16*)(ws + WS_H), (const float*)(ws + WS_SSP), (LAS float*)(F.lds + RSTD_LDS_OFF), -1};
        pg8::gemm_phase<EpiUp, pg8::StaticOrder, 0>(F.lds + RING_OFF, g, S, E);
    } SEAM(9);
    if (IN(10)) { LANES();
        pg8::Gemm g{(const bf16*)(ws + WS_H), (const bf16*)(ws + WS_WDN), M, DM, DFF}; pg8::StaticOrder S; S.init(M, DM, F.G, (int)blockIdx.x, 4);
        EpiResid E{(const bf16*)(ws + WS_X1B), (bf16*)(ws + WS_X2B)};
        pg8::gemm_phase<EpiResid, pg8::StaticOrder, 0, true, true, true>(F.lds + RING_OFF, g, S, E);
    } SEAM(10);
    if (IN(11)) { LANES(); final_norm_rows(F, (const bf16*)(ws + WS_X2B), F.g_final, F.out); }
#undef IN
#undef SEAM
}

#ifndef MK_N_LAUNCHES
#define MK_N_LAUNCHES 1
#endif
extern "C" void kernel_launch(void* const* d_in, const int* in_sizes, int n_in, void* d_out, int out_size, void* d_ws, size_t ws_size, hipStream_t stream) {
    static int grid = 0;
    if (grid == 0) {
        if (n_in != 12 || out_size != M * DM || ws_size < WS_END) { fprintf(stderr, "kernel_launch: unexpected shapes / workspace (n_in %d out %d ws %zu, need %zu)\n", n_in, out_size, ws_size, (size_t)WS_END); grid = -1; return; }
        int dev = 0, cus = 0, per_cu = 0;
        if (hipGetDevice(&dev) != hipSuccess || hipDeviceGetAttribute(&cus, hipDeviceAttributeMultiprocessorCount, dev) != hipSuccess) { grid = -1; return; }
        if (hipFuncSetAttribute((const void*)fwd, hipFuncAttributeMaxDynamicSharedMemorySize, LDS_BYTES) != hipSuccess) { fprintf(stderr, "kernel_launch: hipFuncSetAttribute failed\n"); grid = -1; return; }
        if (hipOccupancyMaxActiveBlocksPerMultiprocessor(&per_cu, (const void*)fwd, NWAVES * 64, LDS_BYTES) != hipSuccess || per_cu < 1) { fprintf(stderr, "kernel_launch: occupancy query reports %d\n", per_cu); }
        (void)hipGetLastError();
        grid = cus;
    }
    if (grid < 0) return;
    if (hipMemsetAsync((char*)d_ws + WS_CTL, 0, CTL_ZERO_BYTES, stream) != hipSuccess) return;
    Args a{};
    for (int i = 0; i < 12; ++i) a.in[i] = (const float*)d_in[i];
    a.out = (float*)d_out; a.ws = (unsigned char*)d_ws; a.pad = 0;
#if MK_N_LAUNCHES == 1
    a.ph_lo = 0; a.ph_hi = N_PHASES; a.li = 0;
    hipLaunchKernelGGL(fwd, dim3(grid), dim3(NWAVES * 64), LDS_BYTES, stream, a);
#else
    for (int p = 0; p < N_PHASES; ++p) { a.ph_lo = p; a.ph_hi = p + 1; a.li = 0; hipLaunchKernelGGL(fwd, dim3(grid), dim3(NWAVES * 64), LDS_BYTES, stream, a); }
#endif
}
```
